# Optimizing an MI355X kernel written in HIP

```python
import jax
import jax.numpy as jnp
from jax import lax
import numpy as np

D_MODEL = 4096
BATCH = 1
SEQ = 8192
DEPTH = 1

PLE_DIM = 256
EPS = 1e-6
NEG_INF = -1e30

MLA_HEADS = 16
Q_LORA = 1024
KV_LORA = 512
QK_NOPE = 128
QK_ROPE = 64
V_HEAD = 128
MLA_WIDTH = MLA_HEADS * V_HEAD
ROPE_THETA = 10000.0
Q_BLOCK = 128

DIL_HEADS = 16
DIL_HEAD_DIM = 128
DIL_WIDTH = DIL_HEADS * DIL_HEAD_DIM
DIL_PATTERNS = ((128, 1), (512, 4), (2048, 16))
ALIBI_MAX_BIAS = 8.0

MIX_WIDTH = MLA_WIDTH + DIL_WIDTH
IN_SPLITS = (Q_LORA, KV_LORA, QK_ROPE, MLA_WIDTH, DIL_WIDTH, DIL_WIDTH, DIL_WIDTH, DIL_WIDTH)
IN_WIDTH = sum(IN_SPLITS)

kernel_name = 'hybrid_mla_dilated_encoder_layer'


def rms_norm(x, g):
    xf = x.astype(jnp.float32)
    y = xf * lax.rsqrt(jnp.mean(xf * xf, axis=-1, keepdims=True) + EPS)
    return (y * g.astype(jnp.float32)).astype(x.dtype)


def apply_rope(t, positions):
    half = t.shape[-1] // 2
    inv = ROPE_THETA ** (-jnp.arange(half, dtype=jnp.float32) / half)
    ang = positions.astype(jnp.float32)[:, :, None] * inv
    ang = ang.reshape(ang.shape[:2] + (1,) * (t.ndim - 3) + (half,))
    cos, sin = jnp.cos(ang), jnp.sin(ang)
    t1 = t[..., :half].astype(jnp.float32)
    t2 = t[..., half:].astype(jnp.float32)
    return jnp.concatenate([t1 * cos - t2 * sin, t1 * sin + t2 * cos], axis=-1).astype(t.dtype)


def mla_attention(q, k, v):
    B, S, H, Dq = q.shape
    nb = S // Q_BLOCK
    scale = Dq ** -0.5
    qb = q.reshape(B, nb, Q_BLOCK, H, Dq).transpose(1, 0, 2, 3, 4)

    def one_block(qi):
        s = jnp.einsum('bqhd,bkhd->bhqk', qi, k, preferred_element_type=jnp.float32) * scale
        pr = jax.nn.softmax(s, axis=-1)
        return jnp.einsum('bhqk,bkhd->bqhd', pr.astype(v.dtype), v)

    out = lax.map(one_block, qb)
    return out.transpose(1, 0, 2, 3, 4).reshape(B, S, H, v.shape[-1])


def dilated_pattern_attention(q, k, v, slopes, window, dilation):
    B, S, H, D = q.shape
    half = window // (2 * dilation)
    L = S // dilation
    nb = -(-L // half)
    Lp = nb * half

    def to_classes(t):
        t = t.reshape(B, L, dilation, H, D).transpose(0, 2, 1, 3, 4)
        return jnp.pad(t, ((0, 0), (0, 0), (0, Lp - L), (0, 0), (0, 0)))

    def band(t):
        tp = jnp.pad(t, ((0, 0), (0, 0), (half, half), (0, 0), (0, 0)))
        tb = tp.reshape(B, dilation, nb + 2, half, H, D)
        return jnp.concatenate([tb[:, :, :-2], tb[:, :, 1:-1], tb[:, :, 2:]], axis=3)

    qb = to_classes(q).reshape(B, dilation, nb, half, H, D)
    kb = band(to_classes(k))
    vb = band(to_classes(v))

    qj = jnp.arange(Lp).reshape(nb, half)
    kj = jnp.arange(nb)[:, None] * half - half + jnp.arange(3 * half)[None, :]
    delta = jnp.abs(qj[:, :, None] - kj[:, None, :])
    valid = (delta <= half) & (kj[:, None, :] >= 0) & (kj[:, None, :] < L)
    alibi = slopes[None, :, None, None] * (dilation * delta).astype(jnp.float32)[:, None]

    s = jnp.einsum('bcnqhd,bcnkhd->bcnhqk', qb, kb, preferred_element_type=jnp.float32)
    s = s * (DIL_HEAD_DIM ** -0.5) - alibi
    s = jnp.where(valid[:, None], s, NEG_INF)
    m = jnp.max(s, axis=-1, keepdims=True)
    e = jnp.exp(s - m)
    l = jnp.sum(e, axis=-1, keepdims=True)
    o = jnp.einsum('bcnhqk,bcnkhd->bcnqhd', e / l, vb.astype(jnp.float32))
    lse = (m + jnp.log(l))[..., 0]

    o = o.reshape(B, dilation, Lp, H, D)[:, :, :L].transpose(0, 2, 1, 3, 4).reshape(B, S, H, D)
    lse = lse.transpose(0, 1, 2, 4, 3).reshape(B, dilation, Lp, H)[:, :, :L]
    lse = lse.transpose(0, 2, 1, 3).reshape(B, S, H)
    return o, lse


def dilated_mixture_attention(q, k, v):
    H = q.shape[2]
    slopes = jnp.asarray(2.0 ** (-ALIBI_MAX_BIAS * np.arange(1, H + 1) / H), jnp.float32)
    results = [dilated_pattern_attention(q, k, v, slopes, w, d) for w, d in DIL_PATTERNS]
    outs = jnp.stack([r[0] for r in results], axis=0)
    lses = jnp.stack([r[1] for r in results], axis=0)
    weights = jax.nn.softmax(lses, axis=0)
    return jnp.sum(weights[..., None] * outs, axis=0)


def setup_inputs(seed: int = 0) -> dict:
    key = jax.random.key(seed)
    ks = jax.random.split(key, 16)

    def dense(k, shape):
        return jax.random.normal(k, shape, jnp.float32) * shape[-2] ** -0.5

    def gain(k, shape):
        return 1.0 + 0.1 * jax.random.normal(k, shape, jnp.float32)

    return {
        'x': jax.random.normal(ks[0], (BATCH, SEQ, D_MODEL), jnp.float32),
        'p': jax.random.normal(ks[1], (DEPTH, BATCH, SEQ, PLE_DIM), jnp.float32),
        'positions': jnp.broadcast_to(jnp.arange(SEQ, dtype=jnp.int32)[None, :], (BATCH, SEQ)),
        'g_mix': gain(ks[2], (DEPTH, D_MODEL)),
        'w_in': dense(ks[3], (DEPTH, D_MODEL, IN_WIDTH)),
        'g_q_latent': gain(ks[4], (DEPTH, Q_LORA)),
        'w_uq': dense(ks[5], (DEPTH, Q_LORA, MLA_HEADS * (QK_NOPE + QK_ROPE))),
        'g_kv_latent': gain(ks[6], (DEPTH, KV_LORA)),
        'w_ukv': dense(ks[7], (DEPTH, KV_LORA, MLA_HEADS * (QK_NOPE + V_HEAD))),
        'g_out_mla': gain(ks[8], (DEPTH, MLA_WIDTH)),
        'g_out_dil': gain(ks[9], (DEPTH, DIL_WIDTH)),
        'w_out': dense(ks[10], (DEPTH, MIX_WIDTH, D_MODEL)),
        'w_ple': dense(ks[11], (DEPTH, PLE_DIM, D_MODEL)),
        'g_ple': gain(ks[12], (DEPTH, D_MODEL)),
        'w_ple_gate': dense(ks[13], (DEPTH, D_MODEL, D_MODEL)),
        'g_final': gain(ks[14], (D_MODEL,)),
    }


def reference(x, p, positions, g_mix, w_in, g_q_latent, w_uq, g_kv_latent, w_ukv,
              g_out_mla, g_out_dil, w_out, w_ple, g_ple, w_ple_gate, g_final):
    B, S, _ = x.shape
    split_idx = [int(v) for v in np.cumsum(IN_SPLITS)[:-1]]
    for i in range(DEPTH):
        h = rms_norm(x, g_mix[i])
        proj = jnp.einsum('bsd,de->bse', h, w_in[i])
        c_q, c_kv, k_rope, gate_a, q_b, k_b, v_b, gate_b = jnp.split(proj, split_idx, axis=-1)

        q_a = jnp.einsum('bsr,re->bse', rms_norm(c_q, g_q_latent[i]), w_uq[i])
        q_a = q_a.reshape(B, S, MLA_HEADS, QK_NOPE + QK_ROPE)
        q_nope, q_pe = q_a[..., :QK_NOPE], apply_rope(q_a[..., QK_NOPE:], positions)
        kv = jnp.einsum('bsr,re->bse', rms_norm(c_kv, g_kv_latent[i]), w_ukv[i])
        kv = kv.reshape(B, S, MLA_HEADS, QK_NOPE + V_HEAD)
        k_nope, v_a = kv[..., :QK_NOPE], kv[..., QK_NOPE:]
        k_pe = jnp.broadcast_to(apply_rope(k_rope, positions)[:, :, None, :], (B, S, MLA_HEADS, QK_ROPE))
        y_a = mla_attention(jnp.concatenate([q_nope, q_pe], axis=-1),
                            jnp.concatenate([k_nope, k_pe], axis=-1), v_a)
        y_a = rms_norm(y_a.reshape(B, S, MLA_WIDTH), g_out_mla[i]) * jax.nn.silu(gate_a)

        shp = (B, S, DIL_HEADS, DIL_HEAD_DIM)
        y_b = dilated_mixture_attention(q_b.reshape(shp), k_b.reshape(shp), v_b.reshape(shp))
        y_b = rms_norm(y_b.reshape(B, S, DIL_WIDTH).astype(x.dtype), g_out_dil[i]) * jax.nn.silu(gate_b)

        x = x + jnp.einsum('bse,ed->bsd', jnp.concatenate([y_a, y_b], axis=-1), w_out[i])

        ple = jnp.einsum('bsc,cd->bsd', p[i], w_ple[i])
        gate = jax.nn.sigmoid(jnp.einsum('bsd,de->bse', rms_norm(x, g_ple[i]), w_ple_gate[i]))
        x = x + ple * gate
    return rms_norm(x, g_final)
```

```cpp
#include <hip/hip_runtime.h>
#include <cstdio>
#include <hip/hip_cooperative_groups.h>
#ifndef FK_EPI_FENCE
#define FK_EPI_FENCE 4
#endif
namespace fk {
namespace cg = cooperative_groups;
#define FK_LAS __attribute__((address_space(3)))
typedef unsigned short bf16_t;
typedef short bf16x8 __attribute__((ext_vector_type(8)));
typedef short s16x4 __attribute__((ext_vector_type(4)));
typedef float f32x4 __attribute__((ext_vector_type(4)));
typedef float f32x2 __attribute__((ext_vector_type(2)));
typedef float f32x16 __attribute__((ext_vector_type(16)));
typedef unsigned u32x4 __attribute__((ext_vector_type(4)));
typedef unsigned u32x2 __attribute__((ext_vector_type(2)));

constexpr int S = 8192, DM = 4096, INW = 11840, NH = 16;
constexpr int N1 = 12032;
constexpr int PW = 11776;
constexpr int PC_CQ = 0, PC_CKV = 1024, PC_GA = 1536, PC_QB = 3584, PC_KB = 5632, PC_VB = 7680, PC_GB = 9728;
constexpr float EPS = 1e-6f;
constexpr float LOG2E = 1.4426950408889634f;
constexpr float QSCALE = 0.07216878364870322f * LOG2E;
constexpr float DSCALE = 0.08838834764831845f * LOG2E;

constexpr size_t MiB = 1u << 20;
constexpr size_t WS_CTL = 0;
constexpr size_t WS_TAB = 1 * MiB;
constexpr size_t WS_WIN = 4 * MiB;
constexpr size_t WS_WUQ = 98 * MiB;
constexpr size_t WS_WUKV = 104 * MiB;
constexpr size_t WS_WOUT = 108 * MiB;
constexpr size_t WS_WPLE = 140 * MiB;
constexpr size_t WS_WPG = 142 * MiB;
constexpr size_t WS_XB = 174 * MiB;
constexpr size_t WS_PB = 238 * MiB;
constexpr size_t WS_PROJ = 242 * MiB;
constexpr size_t WS_Q = 426 * MiB;
constexpr size_t WS_KF = 474 * MiB;
constexpr size_t WS_VF = 522 * MiB;
constexpr size_t WS_Y = 554 * MiB;
constexpr size_t WS_PLE = 618 * MiB;
constexpr size_t WS_END = 682 * MiB;

struct Ptrs {
  const float *x, *p; const int* pos;
  const float *g_mix, *w_in, *g_q, *w_uq, *g_kv, *w_ukv, *g_oa, *g_ob, *w_out, *w_ple, *g_ple, *w_pg, *g_fin;
  float* out; unsigned char* ws;
};
struct W {
  float *ssq_q, *ssq_kv, *ssq_a, *ssq_b, *ssq_x1, *ssq_x2, *rs_x; f32x2* tab;
  bf16_t *win, *wuq, *wukv, *wout, *wple, *wpg, *xb, *pb, *proj, *q, *kf, *vf, *y, *ple; float* dummy;
};
__device__ __forceinline__ W mkW(unsigned char* ws) {
  W w; float* c = (float*)(ws + WS_CTL);
  w.ssq_q = c; w.ssq_kv = c + S; w.ssq_a = c + 2 * S; w.ssq_b = c + 3 * S; w.ssq_x1 = c + 4 * S; w.ssq_x2 = c + 5 * S; w.rs_x = c + 6 * S;
  w.tab = (f32x2*)(ws + WS_TAB);
  w.win = (bf16_t*)(ws + WS_WIN); w.wuq = (bf16_t*)(ws + WS_WUQ); w.wukv = (bf16_t*)(ws + WS_WUKV); w.wout = (bf16_t*)(ws + WS_WOUT);
  w.wple = (bf16_t*)(ws + WS_WPLE); w.wpg = (bf16_t*)(ws + WS_WPG); w.xb = (bf16_t*)(ws + WS_XB); w.pb = (bf16_t*)(ws + WS_PB);
  w.proj = (bf16_t*)(ws + WS_PROJ); w.q = (bf16_t*)(ws + WS_Q); w.kf = (bf16_t*)(ws + WS_KF); w.vf = (bf16_t*)(ws + WS_VF);
  w.y = (bf16_t*)(ws + WS_Y); w.ple = (bf16_t*)(ws + WS_PLE); w.dummy = c + 7 * S;
  return w;
}

__device__ __forceinline__ unsigned cvt_pk_bf16(float lo, float hi) { unsigned r; asm volatile("v_cvt_pk_bf16_f32 %0, %1, %2" : "=v"(r) : "v"(lo), "v"(hi)); return r; }
__device__ __forceinline__ float bf2f(unsigned short b) { return __uint_as_float(((unsigned)b) << 16); }
__device__ __forceinline__ float bflo(unsigned w) { return __uint_as_float(w << 16); }
__device__ __forceinline__ float bfhi(unsigned w) { return __uint_as_float(w & 0xffff0000u); }
__device__ __forceinline__ float wave_sum(float v) {
#pragma unroll
  for (int o = 1; o < 64; o <<= 1) v += __shfl_xor(v, o);
  return v;
}
__device__ __forceinline__ float silu(float g) { return g * __builtin_amdgcn_rcpf(1.f + __builtin_amdgcn_exp2f(-LOG2E * g)); }
__device__ __forceinline__ int crow(int r, int hi) { return (r & 3) + 8 * (r >> 2) + 4 * hi; }

__device__ __forceinline__ int k_img(int r, int c) { return r * 384 + ((c ^ ((r >> 1) & 7)) << 4); }
__device__ __forceinline__ int v_img(int k, int c) { const int kk = (k & ~0xC) | ((k & 4) << 1) | ((k & 8) >> 1); return ((kk >> 3) * 4 + (c >> 5)) * 512 + ((kk & 7) * 32 + (c & 31)) * 2; }
__device__ __forceinline__ int v_rd_base(int lane) { return ((lane & 3) << 3) | (((lane >> 2) & 3) << 6) | (((lane >> 4) & 1) << 5) | (((lane >> 5) & 1) << 8); }
constexpr int v_rd_off(int d0, int ks, int half) { return d0 * 512 + ks * 4096 + half * 2048; }
template <int OFF> __device__ __forceinline__ s16x4 tr_read(int vb) {
  s16x4 r; asm volatile("ds_read_b64_tr_b16 %0, %1 offset:%2" : "=&v"(r) : "v"(vb), "i"(OFF) : "memory"); return r;
}

namespace pg8 {
constexpr int BM = 256, BK = 64, HALF = 128, HTB = HALF * BK * 2, STAGE_BYTES = 8 * HTB, NXCD = 8, WGM = 8;
__device__ __forceinline__ int lds_byte(int r, int c) { const int st = (r >> 4) * 2 + (c >> 5), rr = r & 15, cc = c & 31, ob = rr * 64 + cc * 2; return st * 1024 + (ob ^ (((ob >> 9) & 1) << 5)); }
__device__ __forceinline__ void stage_rc(int b, int& R, int& C) { const int st = b / 1024, sb = b % 1024, swz = sb ^ (((sb >> 9) & 1) << 5); R = (st >> 1) * 16 + swz / 64; C = (st & 1) * 32 + (swz % 64) / 2; }
__device__ __forceinline__ int perm32(int rho) { const int n = rho >> 4, i = rho & 15; return 8 * (i >> 2) + 4 * n + (i & 3); }
struct Unit { int pm, pn; };
struct Gemm { const bf16_t* A; const bf16_t* Bt; int lda, ldb, K; };
struct StaticOrder {
  int nM, nN, nwg, G, c;
  __device__ void init(int M, int N, int G_, int c_) { nM = M / BM; nN = N / BM; nwg = nM * nN; G = G_; c = c_; }
  __device__ bool next(int i, Unit& u) const {
    const long L = (long)i * G + c; if (L >= nwg) return false;
    int wgid = (int)L; { const int q = nwg / NXCD, r = nwg % NXCD, xcd = wgid % NXCD, off = wgid / NXCD; wgid = (xcd < r ? xcd * (q + 1) : r * (q + 1) + (xcd - r) * q) + off; }
    const int nig = WGM * nN, gid = wgid / nig, fm = gid * WGM, gsz = (nM - fm) < WGM ? (nM - fm) : WGM;
    u.pm = fm + ((wgid % nig) % gsz); u.pn = (wgid % nig) / gsz; return true;
  }
};
struct ListOrder {
  int base, count, nN;
  __device__ bool next(int i, Unit& u) const { if (i >= count) return false; const int L = base + i; u.pm = L / nN; u.pn = L - u.pm * nN; return true; }
};
template <class Epi, class Ord = StaticOrder, bool ALIGN_EPI = true, bool SP2 = true>
__device__ __forceinline__ void gemm_phase(FK_LAS unsigned char* lds, const Gemm g, const Ord& S, const Epi& E) {
  const int tid = threadIdx.x, wid = __builtin_amdgcn_readfirstlane(tid >> 6), lane = tid & 63, wr = wid >> 2, wc = wid & 3, fr = lane & 15, fq = lane >> 4;
  const int K = g.K; int nt = K / BK; asm volatile("" : "+s"(nt));
  unsigned voffA[2], voffB[2];
#pragma unroll
  for (int i = 0; i < 2; ++i) { int R, C; stage_rc(tid * 16 + i * 8192, R, C); const int Rb = Epi::PERM ? ((R & ~31) + perm32(R & 31)) : R;
    voffA[i] = (unsigned)(R * g.lda + C) * 2u; voffB[i] = (unsigned)(Rb * g.ldb + C) * 2u; }
  const size_t kstep = (size_t)(BK * 2);
  const size_t hstepA = (size_t)HALF * g.lda * 2, hstepB = (size_t)HALF * g.ldb * 2;
  const size_t tstepA = 2 * hstepA, tstepB = 2 * hstepB;
  const unsigned ldsw = (unsigned)wid * 1024u;
  const int aoff = lds_byte(wr * 64 + fr, fq * 8), boff = lds_byte(wc * 32 + fr, fq * 8);
#define PG8_SA(b, h) (((b) * 2 + (h)) * HTB)
#define PG8_SB(b, h) ((4 + (b) * 2 + (h)) * HTB)
#define PG8_STAGE(bufoff, gbase, voff) do { _Pragma("unroll") for (int _i = 0; _i < 2; ++_i) \
    __builtin_amdgcn_global_load_lds((const unsigned*)((const char*)(gbase) + (voff)[_i]), (FK_LAS unsigned*)(lds + (bufoff) + ldsw + _i * 8192), 16, 0, 0); } while (0)
#define PG8_LDA(dst, b, h) do { _Pragma("unroll") for (int m = 0; m < 4; ++m) _Pragma("unroll") for (int k = 0; k < 2; ++k) dst[m][k] = *(const FK_LAS bf16x8*)(lds + PG8_SA(b, h) + aoff + m * 2048 + k * 1024); } while (0)
#define PG8_LDB(dst, b, h) do { _Pragma("unroll") for (int n = 0; n < 2; ++n) _Pragma("unroll") for (int k = 0; k < 2; ++k) dst[n][k] = *(const FK_LAS bf16x8*)(lds + PG8_SB(b, h) + boff + n * 2048 + k * 1024); } while (0)
#define PG8_MMA(ai, bj, At, Bt) do { __builtin_amdgcn_s_setprio(1); _Pragma("unroll") for (int m = 0; m < 4; ++m) _Pragma("unroll") for (int n = 0; n < 2; ++n) _Pragma("unroll") for (int k = 0; k < 2; ++k) \
    acc[ai][bj][m][n] = __builtin_amdgcn_mfma_f32_16x16x32_bf16(Bt[n][k], At[m][k], acc[ai][bj][m][n], 0, 0, 0); __builtin_amdgcn_s_setprio(0); } while (0)
#define PG8_WAIT_V(n) asm volatile("s_waitcnt vmcnt(" #n ")" ::: "memory")
#define PG8_WAIT_L(n) asm volatile("s_waitcnt lgkmcnt(" #n ")" ::: "memory")
#define PG8_BAR __builtin_amdgcn_s_barrier()
#define PG8_SCHED __builtin_amdgcn_sched_barrier(0)
  Unit cur, nxt; int ui = 0;
  if (!S.next(0, cur)) return;
  f32x4 acc[2][2][4][2];
#pragma unroll
  for (int a = 0; a < 2; ++a)
#pragma unroll
    for (int b = 0; b < 2; ++b)
#pragma unroll
      for (int m = 0; m < 4; ++m)
#pragma unroll
        for (int n = 0; n < 2; ++n) acc[a][b][m][n] = (f32x4){0.f, 0.f, 0.f, 0.f};
  bf16x8 At[4][2], B0[2][2], B1[2][2];
  const char* cA = (const char*)g.A + (size_t)cur.pm * tstepA; const char* cB = (const char*)g.Bt + (size_t)cur.pn * tstepB;
  if constexpr (Epi::BEGIN) E.begin(cur, 0, lds, tid);
  if constexpr (SP2) {
    PG8_STAGE(PG8_SB(0, 0), cB, voffB); PG8_STAGE(PG8_SB(0, 1), cB + hstepB, voffB); PG8_STAGE(PG8_SA(0, 0), cA, voffA); PG8_STAGE(PG8_SA(0, 1), cA + hstepA, voffA);
    if (wr == 1) PG8_BAR;
    PG8_WAIT_V(2); PG8_BAR;
    PG8_STAGE(PG8_SB(1, 0), cB + kstep, voffB); PG8_STAGE(PG8_SA(1, 0), cA + kstep, voffA); PG8_STAGE(PG8_SB(1, 1), cB + hstepB + kstep, voffB);
    PG8_WAIT_V(6); PG8_BAR;
  } else {
    PG8_STAGE(PG8_SB(0, 0), cB, voffB); PG8_STAGE(PG8_SA(0, 0), cA, voffA); PG8_STAGE(PG8_SB(0, 1), cB + hstepB, voffB); PG8_STAGE(PG8_SA(0, 1), cA + hstepA, voffA);
    if (wr == 1) PG8_BAR;
    PG8_WAIT_V(4); PG8_BAR;
    PG8_STAGE(PG8_SB(1, 0), cB + kstep, voffB); PG8_STAGE(PG8_SA(1, 0), cA + kstep, voffA); PG8_STAGE(PG8_SB(1, 1), cB + hstepB + kstep, voffB);
    PG8_WAIT_V(6); PG8_BAR;
  }
  for (;;) {
    const bool has_next = S.next(ui + 1, nxt);
    const char* nA = has_next ? (const char*)g.A + (size_t)nxt.pm * tstepA : cA; const char* nB = has_next ? (const char*)g.Bt + (size_t)nxt.pn * tstepB : cB;
    for (int t = 0; t < nt; t += 2) {
      const bool last = (t == nt - 2);
      const char* a1 = cA + (size_t)(t + 1) * kstep;
      const char* a2 = last ? nA : cA + (size_t)(t + 2) * kstep; const char* b2 = last ? nB : cB + (size_t)(t + 2) * kstep;
      const char* a3 = a2 + kstep; const char* b3 = b2 + kstep;
      if constexpr (Epi::MIDK) { if (t == nt / 2) E.mid(acc, ui & 1, lds, wr, fr); }
      if constexpr (SP2) {
        PG8_LDB(B0, 0, 0); PG8_LDB(B1, 0, 1); PG8_SCHED; PG8_LDA(At, 0, 0); PG8_STAGE(PG8_SA(1, 1), a1 + hstepA, voffA);
        PG8_WAIT_V(8); PG8_WAIT_L(0); PG8_BAR; PG8_MMA(0, 0, At, B0); PG8_MMA(0, 1, At, B1); PG8_BAR; PG8_SCHED;
        PG8_LDA(At, 0, 1); PG8_STAGE(PG8_SB(0, 0), b2, voffB); PG8_STAGE(PG8_SB(0, 1), b2 + hstepB, voffB); PG8_STAGE(PG8_SA(0, 0), a2, voffA);
        PG8_WAIT_V(8); PG8_WAIT_L(0); PG8_BAR; PG8_MMA(1, 0, At, B0); PG8_MMA(1, 1, At, B1); PG8_BAR; PG8_SCHED;
        PG8_LDB(B0, 1, 0); PG8_LDB(B1, 1, 1); PG8_SCHED; PG8_LDA(At, 1, 0); PG8_STAGE(PG8_SA(0, 1), a2 + hstepA, voffA);
        PG8_WAIT_V(8); PG8_WAIT_L(0); PG8_BAR; PG8_MMA(0, 0, At, B0); PG8_MMA(0, 1, At, B1); PG8_BAR; PG8_SCHED;
        PG8_LDA(At, 1, 1); PG8_STAGE(PG8_SB(1, 0), b3, voffB); PG8_STAGE(PG8_SB(1, 1), b3 + hstepB, voffB); PG8_STAGE(PG8_SA(1, 0), a3, voffA);
        PG8_WAIT_V(8); PG8_WAIT_L(0); PG8_BAR; PG8_MMA(1, 0, At, B0); PG8_MMA(1, 1, At, B1); PG8_BAR; PG8_SCHED;
      } else {
        PG8_LDB(B0, 0, 0); PG8_SCHED; PG8_LDA(At, 0, 0); PG8_STAGE(PG8_SA(1, 1), a1 + hstepA, voffA);
        PG8_WAIT_L(8); PG8_BAR; PG8_WAIT_L(0); PG8_MMA(0, 0, At, B0); PG8_BAR; PG8_SCHED;
        PG8_LDB(B1, 0, 1); PG8_STAGE(PG8_SB(0, 0), b2, voffB);
        PG8_BAR; PG8_WAIT_L(0); PG8_MMA(0, 1, At, B1); PG8_BAR;
        PG8_LDA(At, 0, 1); PG8_STAGE(PG8_SA(0, 0), a2, voffA);
        PG8_BAR; PG8_WAIT_L(0); PG8_MMA(1, 0, At, B0); PG8_BAR; PG8_SCHED;
        PG8_STAGE(PG8_SB(0, 1), b2 + hstepB, voffB);
        PG8_WAIT_V(6); PG8_BAR; PG8_MMA(1, 1, At, B1); PG8_BAR;
        PG8_LDB(B0, 1, 0); PG8_SCHED; PG8_LDA(At, 1, 0); PG8_STAGE(PG8_SA(0, 1), a2 + hstepA, voffA);
        PG8_WAIT_L(8); PG8_BAR; PG8_WAIT_L(0); PG8_MMA(0, 0, At, B0); PG8_BAR; PG8_SCHED;
        PG8_LDB(B1, 1, 1); PG8_STAGE(PG8_SB(1, 0), b3, voffB);
        PG8_BAR; PG8_WAIT_L(0); PG8_MMA(0, 1, At, B1); PG8_BAR;
        PG8_LDA(At, 1, 1); PG8_STAGE(PG8_SA(1, 0), a3, voffA);
        PG8_BAR; PG8_WAIT_L(0); PG8_MMA(1, 0, At, B0); PG8_BAR; PG8_SCHED;
        PG8_STAGE(PG8_SB(1, 1), b3 + hstepB, voffB);
        PG8_WAIT_V(6); PG8_BAR; PG8_MMA(1, 1, At, B1); PG8_BAR;
      }
    }
    if constexpr (ALIGN_EPI) { if (wr == 0) PG8_BAR; }
    if constexpr (Epi::BEGIN) E.epi(acc, cur, ui & 1, lds, wr, wc, fr, fq); else E(acc, cur, wr, wc, fr, fq);
    if (!has_next) break;
#pragma unroll
    for (int a = 0; a < 2; ++a)
#pragma unroll
      for (int b = 0; b < 2; ++b)
#pragma unroll
        for (int m = 0; m < 4; ++m)
#pragma unroll
          for (int n = 0; n < 2; ++n) acc[a][b][m][n] = (f32x4){0.f, 0.f, 0.f, 0.f};
    cur = nxt; cA = nA; cB = nB; ++ui;
    if constexpr (Epi::BEGIN) E.begin(cur, ui & 1, lds, tid);
    if constexpr (ALIGN_EPI) { if (wr == 1) PG8_BAR; }
  }
  PG8_WAIT_V(0);
  if constexpr (!ALIGN_EPI) { if (wr == 0) PG8_BAR; }
  PG8_BAR;
#undef PG8_SA
#undef PG8_SB
#undef PG8_STAGE
#undef PG8_LDA
#undef PG8_LDB
#undef PG8_MMA
#undef PG8_WAIT_V
#undef PG8_WAIT_L
#undef PG8_BAR
#undef PG8_SCHED
}
}

typedef f32x4 Acc[2][2][4][2];
__device__ __forceinline__ u32x4 pack8(f32x4 a, f32x4 b) { u32x4 w; w.x = cvt_pk_bf16(a[0], a[1]); w.y = cvt_pk_bf16(a[2], a[3]); w.z = cvt_pk_bf16(b[0], b[1]); w.w = cvt_pk_bf16(b[2], b[3]); return w; }
__device__ __forceinline__ void rope8(f32x4& v0, f32x4& v1, const f32x2* tabrow, int i0) {
  const f32x2 c0 = tabrow[i0], c1 = tabrow[i0 + 1], c2 = tabrow[i0 + 2], c3 = tabrow[i0 + 3];
  const f32x4 a = v0, b = v1;
  v0[0] = a[0] * c0.x - a[1] * c0.y; v0[1] = a[0] * c0.y + a[1] * c0.x; v0[2] = a[2] * c1.x - a[3] * c1.y; v0[3] = a[2] * c1.y + a[3] * c1.x;
  v1[0] = b[0] * c2.x - b[1] * c2.y; v1[1] = b[0] * c2.y + b[1] * c2.x; v1[2] = b[2] * c3.x - b[3] * c3.y; v1[3] = b[2] * c3.y + b[3] * c3.x;
}
struct Epi1 {
  static constexpr bool PERM = true, MIDK = false, BEGIN = false;
  bf16_t* proj; const float* rsx; float* ssq_q; float* ssq_kv; const f32x2* tab; bf16_t* kf;
  __device__ __forceinline__ void mid(Acc&, int, FK_LAS unsigned char*, int, int) const {}
  __device__ __forceinline__ void operator()(const Acc& acc, const pg8::Unit& u, int wr, int wc, int fr, int fq) const {
    const int row0 = u.pm * 256 + wr * 64 + fr;
    if (u.pn < 46) {
      const int col0 = u.pn * 256 + wc * 32 + 8 * fq; const float cs = (u.pn >= PC_QB / 256 && u.pn < PC_KB / 256) ? DSCALE : 1.f;
#pragma unroll
      for (int ai = 0; ai < 2; ++ai)
#pragma unroll
        for (int m = 0; m < 4; ++m) { const int row = row0 + ai * 128 + m * 16; const float rs = rsx[row] * cs; float ss = 0.f;
          bf16_t* rowp = proj + (size_t)row * PW + col0;
#pragma unroll
          for (int bj = 0; bj < 2; ++bj) { const f32x4 v0 = acc[ai][bj][m][0] * rs, v1 = acc[ai][bj][m][1] * rs;
            ss += (v0[0] * v0[0] + v0[1] * v0[1]) + (v0[2] * v0[2] + v0[3] * v0[3]) + (v1[0] * v1[0] + v1[1] * v1[1]) + (v1[2] * v1[2] + v1[3] * v1[3]);
            *(u32x4*)(rowp + bj * 128) = pack8(v0, v1); }
          if (u.pn < 6) { ss += __shfl_xor(ss, 16); ss += __shfl_xor(ss, 32); if (fq == 0) atomicAdd((u.pn < 4 ? ssq_q : ssq_kv) + row, ss); } }
    } else if (wc < 2) {
#pragma unroll
      for (int ai = 0; ai < 2; ++ai)
#pragma unroll
        for (int m = 0; m < 4; ++m) { const int row = row0 + ai * 128 + m * 16; const float rs = rsx[row];
          f32x4 v0 = acc[ai][0][m][0] * rs, v1 = acc[ai][0][m][1] * rs;
          rope8(v0, v1, tab + (size_t)row * 32, 16 * wc + 4 * fq);
          const u32x4 w = pack8(v0, v1);
          const int tile = row >> 6, r = row & 63, c = 16 + 4 * wc + fq;
#pragma unroll
          for (int h = 0; h < NH; ++h) *(u32x4*)((char*)kf + ((size_t)(h * 128 + tile)) * 24576 + k_img(r, c)) = w; }
    }
  }
};
struct Epi2a {
  static constexpr bool PERM = true, MIDK = false, BEGIN = false;
  bf16_t* q; const float* ssq_q; const f32x2* tab;
  __device__ __forceinline__ void mid(Acc&, int, FK_LAS unsigned char*, int, int) const {}
  __device__ __forceinline__ void operator()(const Acc& acc, const pg8::Unit& u, int wr, int wc, int fr, int fq) const {
    const int row0 = u.pm * 256 + wr * 64 + fr;
#pragma unroll
    for (int ai = 0; ai < 2; ++ai)
#pragma unroll
      for (int m = 0; m < 4; ++m) { const int row = row0 + ai * 128 + m * 16; const float rs = rsqrtf(ssq_q[row] * (1.f / 1024.f) + EPS) * QSCALE;
#pragma unroll
        for (int bj = 0; bj < 2; ++bj) { const int col = u.pn * 256 + bj * 128 + wc * 32 + 8 * fq; const int g64 = col >> 6, h = g64 / 3, part = g64 - 3 * h;
          f32x4 v0 = acc[ai][bj][m][0] * rs, v1 = acc[ai][bj][m][1] * rs;
          if (part == 2) rope8(v0, v1, tab + (size_t)row * 32, (col & 63) >> 1);
          *(u32x4*)(q + ((size_t)h * S + row) * 192 + part * 64 + (col & 63)) = pack8(v0, v1); } }
  }
};
struct Epi2b {
  static constexpr bool PERM = true, MIDK = false, BEGIN = false;
  bf16_t* kf; bf16_t* vf; const float* ssq_kv;
  __device__ __forceinline__ void mid(Acc&, int, FK_LAS unsigned char*, int, int) const {}
  __device__ __forceinline__ void operator()(const Acc& acc, const pg8::Unit& u, int wr, int wc, int fr, int fq) const {
    const int row0 = u.pm * 256 + wr * 64 + fr; const int h = u.pn; const int e = wc * 32 + 8 * fq;
#pragma unroll
    for (int ai = 0; ai < 2; ++ai)
#pragma unroll
      for (int m = 0; m < 4; ++m) { const int row = row0 + ai * 128 + m * 16; const float rs = rsqrtf(ssq_kv[row] * (1.f / 512.f) + EPS);
        const int tile = row >> 6, r = row & 63;
        *(u32x4*)((char*)kf + ((size_t)(h * 128 + tile)) * 24576 + k_img(r, e >> 3)) = pack8(acc[ai][0][m][0] * rs, acc[ai][0][m][1] * rs);
        *(u32x4*)((char*)vf + ((size_t)(h * 128 + tile)) * 16384 + v_img(r, e)) = pack8(acc[ai][1][m][0] * rs, acc[ai][1][m][1] * rs); }
  }
};
struct EpiPle {
  static constexpr bool PERM = true, MIDK = false, BEGIN = false;
  bf16_t* o; int ldc;
  __device__ __forceinline__ void mid(Acc&, int, FK_LAS unsigned char*, int, int) const {}
  __device__ __forceinline__ void operator()(const Acc& acc, const pg8::Unit& u, int wr, int wc, int fr, int fq) const {
    const int row0 = u.pm * 256 + wr * 64 + fr, col0 = u.pn * 256 + wc * 32 + 8 * fq;
#pragma unroll
    for (int ai = 0; ai < 2; ++ai)
#pragma unroll
      for (int m = 0; m < 4; ++m) { bf16_t* rowp = o + (size_t)(row0 + ai * 128 + m * 16) * ldc + col0;
#pragma unroll
        for (int bj = 0; bj < 2; ++bj) *(u32x4*)(rowp + bj * 128) = pack8(acc[ai][bj][m][0], acc[ai][bj][m][1]); }
  }
};
constexpr int EPI4_LDS = 131072 + 4096;
struct Epi4 {
  static constexpr bool PERM = false, MIDK = true, BEGIN = true;
  const float* x; float* out; bf16_t* x1b; const float* ssq_a; const float* ssq_b; float* ssq_x1;
  __device__ __forceinline__ void begin(const pg8::Unit& u, int par, FK_LAS unsigned char* lds, int tid) const {
    if (tid < 256) { const int row = u.pm * 256 + tid; FK_LAS float* f = (FK_LAS float*)(lds + EPI4_LDS + par * 2048);
      const float ra = rsqrtf(ssq_a[row] * (1.f / 2048.f) + EPS), rb = rsqrtf(ssq_b[row] * (1.f / 2048.f) + EPS); f[tid] = ra / rb; f[256 + tid] = rb; }
  }
  __device__ __forceinline__ void mid(Acc& acc, int par, FK_LAS unsigned char* lds, int wr, int fr) const {
    const FK_LAS float* f = (const FK_LAS float*)(lds + EPI4_LDS + par * 2048) + wr * 64 + fr;
#pragma unroll
    for (int ai = 0; ai < 2; ++ai)
#pragma unroll
      for (int m = 0; m < 4; ++m) { const float s = f[ai * 128 + m * 16];
#pragma unroll
        for (int bj = 0; bj < 2; ++bj)
#pragma unroll
          for (int n = 0; n < 2; ++n) acc[ai][bj][m][n] *= s; }
  }
  __device__ __forceinline__ void epi(const Acc& acc, const pg8::Unit& u, int par, FK_LAS unsigned char* lds, int wr, int wc, int fr, int fq) const {
    const int row0 = u.pm * 256 + wr * 64 + fr, col0 = u.pn * 256 + wc * 32 + 4 * fq;
    const FK_LAS float* f = (const FK_LAS float*)(lds + EPI4_LDS + par * 2048) + 256 + wr * 64 + fr;
#pragma unroll
    for (int ai = 0; ai < 2; ++ai)
#pragma unroll
      for (int m = 0; m < 4; ++m) { const int row = row0 + ai * 128 + m * 16; const float rb = f[ai * 128 + m * 16]; float ss = 0.f;
        const size_t off = (size_t)row * DM + col0;
#pragma unroll
        for (int bj = 0; bj < 2; ++bj)
#pragma unroll
          for (int n = 0; n < 2; ++n) { const f32x4 xv = *(const f32x4*)(x + off + bj * 128 + n * 16); const f32x4 v = xv + acc[ai][bj][m][n] * rb;
            ss += (v[0] * v[0] + v[1] * v[1]) + (v[2] * v[2] + v[3] * v[3]);
            u32x2 w; w.x = cvt_pk_bf16(v[0], v[1]); w.y = cvt_pk_bf16(v[2], v[3]); *(u32x2*)(x1b + off + bj * 128 + n * 16) = w; }
        ss += __shfl_xor(ss, 16); ss += __shfl_xor(ss, 32); if (fq == 0) atomicAdd(ssq_x1 + row, ss);
        if (FK_EPI_FENCE == 1 || (FK_EPI_FENCE == 2 && (m & 1)) || (FK_EPI_FENCE == 4 && m == 3)) asm volatile("" ::: "memory"); }
  }
  __device__ __forceinline__ void operator()(const Acc&, const pg8::Unit&, int, int, int, int) const {}
};
struct Epi5 {
  static constexpr bool PERM = false, MIDK = false, BEGIN = false;
  const bf16_t* x1b; bf16_t* x2b; const bf16_t* ple; const float* ssq_x1; float* ssq_x2;
  __device__ __forceinline__ void mid(Acc&, int, FK_LAS unsigned char*, int, int) const {}
  __device__ __forceinline__ void operator()(const Acc& acc, const pg8::Unit& u, int wr, int wc, int fr, int fq) const {
    const int row0 = u.pm * 256 + wr * 64 + fr, col0 = u.pn * 256 + wc * 32 + 4 * fq;
#pragma unroll
    for (int ai = 0; ai < 2; ++ai)
#pragma unroll
      for (int m = 0; m < 4; ++m) { const int row = row0 + ai * 128 + m * 16; const float r1 = rsqrtf(ssq_x1[row] * (1.f / 4096.f) + EPS) * -LOG2E; float ss = 0.f;
        const size_t off = (size_t)row * DM + col0;
#pragma unroll
        for (int bj = 0; bj < 2; ++bj)
#pragma unroll
          for (int n = 0; n < 2; ++n) { const u32x2 xw = *(const u32x2*)(x1b + off + bj * 128 + n * 16); const u32x2 pw = *(const u32x2*)(ple + off + bj * 128 + n * 16);
            const f32x4 z = acc[ai][bj][m][n] * r1; f32x4 v;
            v[0] = bflo(xw.x) + bflo(pw.x) * __builtin_amdgcn_rcpf(1.f + __builtin_amdgcn_exp2f(z[0])); v[1] = bfhi(xw.x) + bfhi(pw.x) * __builtin_amdgcn_rcpf(1.f + __builtin_amdgcn_exp2f(z[1]));
            v[2] = bflo(xw.y) + bflo(pw.y) * __builtin_amdgcn_rcpf(1.f + __builtin_amdgcn_exp2f(z[2])); v[3] = bfhi(xw.y) + bfhi(pw.y) * __builtin_amdgcn_rcpf(1.f + __builtin_amdgcn_exp2f(z[3]));
            ss += (v[0] * v[0] + v[1] * v[1]) + (v[2] * v[2] + v[3] * v[3]);
            u32x2 w; w.x = cvt_pk_bf16(v[0], v[1]); w.y = cvt_pk_bf16(v[2], v[3]); *(u32x2*)(x2b + off + bj * 128 + n * 16) = w; }
        ss += __shfl_xor(ss, 16); ss += __shfl_xor(ss, 32); if (fq == 0) atomicAdd(ssq_x2 + row, ss);
        if (FK_EPI_FENCE == 1 || (FK_EPI_FENCE == 2 && (m & 1)) || (FK_EPI_FENCE == 4 && m == 3)) asm volatile("" ::: "memory"); }
  }
};

__device__ __forceinline__ void transpose_item(const float* Wm, int N, const float* gain, bf16_t* WT, int K, int k0, int n0, int drow0, int dstep, FK_LAS float* scr, int lane) {
  const int nq = lane & 7, kr = lane >> 3;
  f32x4 v[8]; float gk[8];
#pragma unroll
  for (int i = 0; i < 8; ++i) v[i] = *(const f32x4*)(Wm + (size_t)(k0 + kr + 8 * i) * N + n0 + 4 * nq);
#pragma unroll
  for (int i = 0; i < 8; ++i) gk[i] = gain ? gain[k0 + kr + 8 * i] : 1.f;
#pragma unroll
  for (int i = 0; i < 8; ++i) { FK_LAS float* d = scr + (kr + 8 * i) * 33 + 4 * nq; const f32x4 t = v[i] * gk[i]; d[0] = t[0]; d[1] = t[1]; d[2] = t[2]; d[3] = t[3]; }
  asm volatile("s_waitcnt lgkmcnt(0)" ::: "memory");
  const int c = lane & 7;
#pragma unroll
  for (int j = 0; j < 4; ++j) { const int n = (lane >> 3) + 8 * j; const FK_LAS float* s = scr + (8 * c) * 33 + n;
    u32x4 o; o.x = cvt_pk_bf16(s[0 * 33], s[1 * 33]); o.y = cvt_pk_bf16(s[2 * 33], s[3 * 33]); o.z = cvt_pk_bf16(s[4 * 33], s[5 * 33]); o.w = cvt_pk_bf16(s[6 * 33], s[7 * 33]);
    *(u32x4*)(WT + (size_t)(drow0 + n * dstep) * K + k0 + 8 * c) = o; }
  asm volatile("s_waitcnt lgkmcnt(0)" ::: "memory");
}
__device__ __forceinline__ void prologue(const Ptrs& P, const W& w, FK_LAS unsigned char* lds, int vcu, int G) {
  const int tid = threadIdx.x, lane = tid & 63, wave = tid >> 6;
  FK_LAS float* scr = (FK_LAS float*)(lds + wave * 16384);
  const int gw = vcu * 8 + wave, NGW = G * 8;
  const int gt = vcu * 512 + tid, NGT = G * 512;
  constexpr int I_IN = 64 * (INW / 32), I_UQ = 16 * 96, I_UKV = 8 * 128, I_OUT = 64 * 128, I_PLE = 4 * 128, I_PG = 64 * 128;
  constexpr int NIT = I_IN + I_UQ + I_UKV + I_OUT + I_PLE + I_PG;
  for (int it = gw; it < NIT; it += NGW) {
    int r = it;
    if (r < I_IN) { const int nb = r % (INW / 32), kb = r / (INW / 32), n0 = nb * 32; int d0, st = 1;
      if (n0 < 1536) d0 = n0; else if (n0 == 1536) { d0 = PW; st = 2; } else if (n0 == 1568) { d0 = PW + 1; st = 2; } else d0 = n0 - 64;
      transpose_item(P.w_in, INW, P.g_mix, w.win, 4096, kb * 64, n0, d0, st, scr, lane); continue; } r -= I_IN;
    if (r < I_UQ) { const int nb = r % 96, kb = r / 96, n0 = nb * 32, h = n0 / 192, d = n0 - h * 192; int d0 = n0, st = 1;
      if (d == 128) { d0 = h * 192 + 128; st = 2; } else if (d == 160) { d0 = h * 192 + 129; st = 2; }
      transpose_item(P.w_uq, 3072, P.g_q, w.wuq, 1024, kb * 64, n0, d0, st, scr, lane); continue; } r -= I_UQ;
    if (r < I_UKV) { const int nb = r % 128, kb = r / 128; transpose_item(P.w_ukv, 4096, P.g_kv, w.wukv, 512, kb * 64, nb * 32, nb * 32, 1, scr, lane); continue; } r -= I_UKV;
    if (r < I_OUT) { const int nb = r % 128, kb = r / 128; transpose_item(P.w_out, 4096, kb < 32 ? P.g_oa : P.g_ob - 2048, w.wout, 4096, kb * 64, nb * 32, nb * 32, 1, scr, lane); continue; } r -= I_OUT;
    if (r < I_PLE) { const int nb = r % 128, kb = r / 128; transpose_item(P.w_ple, 4096, nullptr, w.wple, 256, kb * 64, nb * 32, nb * 32, 1, scr, lane); continue; } r -= I_PLE;
    { const int nb = r % 128, kb = r / 128; transpose_item(P.w_pg, 4096, P.g_ple, w.wpg, 4096, kb * 64, nb * 32, nb * 32, 1, scr, lane); }
  }
  for (int row = gw; row < S; row += NGW) {
    const f32x4* xr = (const f32x4*)(P.x + (size_t)row * DM) + lane; u32x2* o8 = (u32x2*)(w.xb + (size_t)row * DM) + lane; float s = 0.f;
#pragma unroll
    for (int j = 0; j < 16; ++j) { const f32x4 v = xr[64 * j]; s += (v[0] * v[0] + v[1] * v[1]) + (v[2] * v[2] + v[3] * v[3]); u32x2 o; o.x = cvt_pk_bf16(v[0], v[1]); o.y = cvt_pk_bf16(v[2], v[3]); o8[64 * j] = o; }
    s = wave_sum(s);
    if (lane == 0) w.rs_x[row] = rsqrtf(s * (1.f / 4096.f) + EPS);
  }
  for (int i = gt; i < S * 256 / 8; i += NGT) { const f32x4 a = ((const f32x4*)P.p)[2 * i], b = ((const f32x4*)P.p)[2 * i + 1]; ((u32x4*)w.pb)[i] = pack8(a, b); }
  for (int i = gt; i < S * 32; i += NGT) { const int s = i >> 5, j = i & 31; const float inv = powf(10000.f, -(float)j / 32.f); const float ang = (float)P.pos[s] * inv; f32x2 cs; cs.x = cosf(ang); cs.y = sinf(ang); w.tab[i] = cs; }
  for (int i = gt; i < 6 * S; i += NGT) w.ssq_q[i] = 0.f;
  for (int i = gt; i < (N1 - INW) * 4096 / 8; i += NGT) ((u32x4*)(w.win + (size_t)INW * 4096))[i] = (u32x4){0u, 0u, 0u, 0u};
}

constexpr int STG_ROW = 272, STG_BYTES = 32 * STG_ROW;
__device__ __forceinline__ void stage_tile(FK_LAS unsigned char* st, const f32x16 (&o)[4], const FK_LAS float* lsum, int r32, int hi) {
#pragma unroll
  for (int r = 0; r < 16; ++r) { const float rl = __builtin_amdgcn_rcpf(lsum[crow(r, hi)]); FK_LAS unsigned short* rowp = (FK_LAS unsigned short*)(st + crow(r, hi) * STG_ROW) + r32;
#pragma unroll
    for (int d0 = 0; d0 < 4; ++d0) rowp[d0 * 32] = (unsigned short)(cvt_pk_bf16(o[d0][r] * rl, 0.f) & 0xffffu); }
  asm volatile("s_waitcnt lgkmcnt(0)" ::: "memory");
}
namespace mla {
constexpr int KB = 24576, VB = 16384, K_OFF = 0, V_OFF = 3 * KB, SCR_OFF = 3 * KB + 3 * VB, LDS_BYTES = SCR_OFF + 8 * 256;
constexpr float THR2 = 11.5f;
__device__ __forceinline__ void partialSM(f32x16& p0, f32x16& p1, float& m_reg, float& alpha) {
  float pmax = p0[0];
#pragma unroll
  for (int r = 1; r < 16; ++r) pmax = fmaxf(pmax, p0[r]);
#pragma unroll
  for (int r = 0; r < 16; ++r) pmax = fmaxf(pmax, p1[r]);
  { auto rr = __builtin_amdgcn_permlane32_swap(__float_as_uint(pmax), __float_as_uint(pmax), false, false); pmax = fmaxf(__uint_as_float(rr[0]), __uint_as_float(rr[1])); }
  float mn;
  if (__builtin_expect(__all(pmax - m_reg <= THR2), 1)) { mn = m_reg; alpha = 1.f; }
  else { mn = fmaxf(m_reg, pmax); alpha = __builtin_amdgcn_exp2f(m_reg - mn); m_reg = mn; }
#pragma unroll
  for (int r = 0; r < 16; ++r) p0[r] = p0[r] - mn;
#pragma unroll
  for (int r = 0; r < 16; ++r) p1[r] = p1[r] - mn;
#pragma unroll
  for (int r = 0; r < 16; ++r) p0[r] = __builtin_amdgcn_exp2f(p0[r]);
}
#define FK_PK4(P, BASE, OUT) do { unsigned a0 = cvt_pk_bf16(P[BASE + 0], P[BASE + 1]), a1 = cvt_pk_bf16(P[BASE + 2], P[BASE + 3]); \
    unsigned b0 = cvt_pk_bf16(P[BASE + 4], P[BASE + 5]), b1 = cvt_pk_bf16(P[BASE + 6], P[BASE + 7]); \
    auto r0 = __builtin_amdgcn_permlane32_swap(a0, b0, false, false); auto r1 = __builtin_amdgcn_permlane32_swap(a1, b1, false, false); \
    u32x4 w_ = {r0[0], r1[0], r0[1], r1[1]}; OUT = *reinterpret_cast<bf16x8*>(&w_); } while (0)
__device__ __forceinline__ void finishSM_a(f32x16& p0, f32x16& p1, float alpha, float& l_reg) {
#pragma unroll
  for (int r = 0; r < 16; ++r) p1[r] = __builtin_amdgcn_exp2f(p1[r]);
  float ps = 0.f;
#pragma unroll
  for (int r = 0; r < 16; ++r) ps += p0[r];
#pragma unroll
  for (int r = 0; r < 16; ++r) ps += p1[r];
  { auto rr = __builtin_amdgcn_permlane32_swap(__float_as_uint(ps), __float_as_uint(ps), false, false); ps = __uint_as_float(rr[0]) + __uint_as_float(rr[1]); }
  l_reg = l_reg * alpha + ps;
}
__device__ __forceinline__ void finishSM_b(const f32x16& p0, const f32x16& p1, bf16x8& pa0, bf16x8& pa1, bf16x8& pa2, bf16x8& pa3) {
  FK_PK4(p0, 0, pa0); FK_PK4(p0, 8, pa1); FK_PK4(p1, 0, pa2); FK_PK4(p1, 8, pa3);
}
#define FK_PKV(L, H) (bf16x8){L[0], L[1], L[2], L[3], H[0], H[1], H[2], H[3]}
#define FK_KRD(A_, B_, D0_) asm volatile("ds_read_b128 %0, %2 offset:%3\n\tds_read_b128 %1, %2 offset:%4" : "=&v"(A_), "=&v"(B_) : "v"(ka[(D0_) & 3]), "i"(128 * ((D0_) >> 2)), "i"(128 * ((D0_) >> 2) + 12288) : "memory")
#define FK_KWAIT(N_, A_, B_) asm volatile("s_waitcnt lgkmcnt(" #N_ ")" : "+v"(A_), "+v"(B_) :: "memory")
#ifndef FK_KDEPTH
#define FK_KDEPTH 2
#endif
#ifndef FK_PRIO
#define FK_PRIO 0
#endif
#define FK_KSTEP(P0, P1, D0_, N_, A_, B_) do { FK_KWAIT(N_, A_, B_); if (FK_PRIO) __builtin_amdgcn_s_setprio(1); P0 = __builtin_amdgcn_mfma_f32_32x32x16_bf16(A_, qr[D0_], P0, 0, 0, 0); P1 = __builtin_amdgcn_mfma_f32_32x32x16_bf16(B_, qr[D0_], P1, 0, 0, 0); if (FK_PRIO) __builtin_amdgcn_s_setprio(0); \
    if ((D0_) + FK_KDEPTH < 12) FK_KRD(A_, B_, (D0_) + FK_KDEPTH < 12 ? (D0_) + FK_KDEPTH : 0); } while (0)
#if FK_KDEPTH == 3
#define FK_QKT(P0, P1, KBASE) do { int ka[4]; _Pragma("unroll") for (int q_ = 0; q_ < 4; ++q_) ka[q_] = kb[q_] + (KBASE); \
    bf16x8 xa, xb, ya, yb, za, zb; P0 = (f32x16){}; P1 = (f32x16){}; FK_KRD(xa, xb, 0); FK_KRD(ya, yb, 1); FK_KRD(za, zb, 2); \
    FK_KSTEP(P0, P1, 0, 4, xa, xb); FK_KSTEP(P0, P1, 1, 4, ya, yb); FK_KSTEP(P0, P1, 2, 4, za, zb); FK_KSTEP(P0, P1, 3, 4, xa, xb); FK_KSTEP(P0, P1, 4, 4, ya, yb); FK_KSTEP(P0, P1, 5, 4, za, zb); \
    FK_KSTEP(P0, P1, 6, 4, xa, xb); FK_KSTEP(P0, P1, 7, 4, ya, yb); FK_KSTEP(P0, P1, 8, 4, za, zb); FK_KSTEP(P0, P1, 9, 4, xa, xb); FK_KSTEP(P0, P1, 10, 2, ya, yb); FK_KSTEP(P0, P1, 11, 0, za, zb); } while (0)
#else
#define FK_QKT(P0, P1, KBASE) do { int ka[4]; _Pragma("unroll") for (int q_ = 0; q_ < 4; ++q_) ka[q_] = kb[q_] + (KBASE); \
    bf16x8 xa, xb, ya, yb; P0 = (f32x16){}; P1 = (f32x16){}; FK_KRD(xa, xb, 0); FK_KRD(ya, yb, 1); \
    FK_KSTEP(P0, P1, 0, 2, xa, xb); FK_KSTEP(P0, P1, 1, 2, ya, yb); FK_KSTEP(P0, P1, 2, 2, xa, xb); FK_KSTEP(P0, P1, 3, 2, ya, yb); FK_KSTEP(P0, P1, 4, 2, xa, xb); FK_KSTEP(P0, P1, 5, 2, ya, yb); \
    FK_KSTEP(P0, P1, 6, 2, xa, xb); FK_KSTEP(P0, P1, 7, 2, ya, yb); FK_KSTEP(P0, P1, 8, 2, xa, xb); FK_KSTEP(P0, P1, 9, 2, ya, yb); FK_KSTEP(P0, P1, 10, 2, xa, xb); FK_KSTEP(P0, P1, 11, 0, ya, yb); } while (0)
#endif
#define FK_TRD8(L0, H0, L1, H1, L2, H2, L3, H3, D0_) do { L0 = tr_read<v_rd_off(D0_, 0, 0)>(vb_); H0 = tr_read<v_rd_off(D0_, 0, 1)>(vb_); L1 = tr_read<v_rd_off(D0_, 1, 0)>(vb_); H1 = tr_read<v_rd_off(D0_, 1, 1)>(vb_); \
    L2 = tr_read<v_rd_off(D0_, 2, 0)>(vb_); H2 = tr_read<v_rd_off(D0_, 2, 1)>(vb_); L3 = tr_read<v_rd_off(D0_, 3, 0)>(vb_); H3 = tr_read<v_rd_off(D0_, 3, 1)>(vb_); } while (0)
#define FK_VWAIT(N_, L0, H0, L1, H1, L2, H2, L3, H3) asm volatile("s_waitcnt lgkmcnt(" #N_ ")" : "+v"(L0), "+v"(H0), "+v"(L1), "+v"(H1), "+v"(L2), "+v"(H2), "+v"(L3), "+v"(H3) :: "memory")
#define FK_PV4(OD, L0, H0, L1, H1, L2, H2, L3, H3) do { if (FK_PRIO) __builtin_amdgcn_s_setprio(1); OD = __builtin_amdgcn_mfma_f32_32x32x16_bf16(pa0, FK_PKV(L0, H0), OD, 0, 0, 0); OD = __builtin_amdgcn_mfma_f32_32x32x16_bf16(pa1, FK_PKV(L1, H1), OD, 0, 0, 0); \
    OD = __builtin_amdgcn_mfma_f32_32x32x16_bf16(pa2, FK_PKV(L2, H2), OD, 0, 0, 0); OD = __builtin_amdgcn_mfma_f32_32x32x16_bf16(pa3, FK_PKV(L3, H3), OD, 0, 0, 0); if (FK_PRIO) __builtin_amdgcn_s_setprio(0); } while (0)
#define FK_PV_DECL s16x4 al0, ah0, al1, ah1, al2, ah2, al3, ah3, bl0, bh0, bl1, bh1, bl2, bh2, bl3, bh3
#define FK_PV_ISSUE(VBASE) const int vb_ = vb0 + (VBASE); FK_TRD8(al0, ah0, al1, ah1, al2, ah2, al3, ah3, 0); FK_TRD8(bl0, bh0, bl1, bh1, bl2, bh2, bl3, bh3, 1)
#define FK_PV_REST() do { \
    FK_VWAIT(8, al0, ah0, al1, ah1, al2, ah2, al3, ah3); FK_PV4(o[0], al0, ah0, al1, ah1, al2, ah2, al3, ah3); FK_TRD8(al0, ah0, al1, ah1, al2, ah2, al3, ah3, 2); \
    FK_VWAIT(8, bl0, bh0, bl1, bh1, bl2, bh2, bl3, bh3); FK_PV4(o[1], bl0, bh0, bl1, bh1, bl2, bh2, bl3, bh3); FK_TRD8(bl0, bh0, bl1, bh1, bl2, bh2, bl3, bh3, 3); \
    FK_VWAIT(8, al0, ah0, al1, ah1, al2, ah2, al3, ah3); FK_PV4(o[2], al0, ah0, al1, ah1, al2, ah2, al3, ah3); \
    FK_VWAIT(0, bl0, bh0, bl1, bh1, bl2, bh2, bl3, bh3); FK_PV4(o[3], bl0, bh0, bl1, bh1, bl2, bh2, bl3, bh3); } while (0)
__device__ __forceinline__ void epilogue(FK_LAS unsigned char* lds, const W& w, int h, int q0, const f32x16 (&o)[4], float l_reg) {
  const int lane = (int)__builtin_amdgcn_mbcnt_hi(~0u, __builtin_amdgcn_mbcnt_lo(~0u, 0u)); const int r32 = lane & 31, hi = lane >> 5;
  const int wid = __builtin_amdgcn_readfirstlane((int)threadIdx.x >> 6);
  FK_LAS float* al_l = (FK_LAS float*)(lds + SCR_OFF + wid * 256);
  if (hi == 0) al_l[r32] = l_reg; asm volatile("s_waitcnt lgkmcnt(0)" ::: "memory");
  const int rowb = q0 + wid * 32;
#pragma unroll
  for (int r = 0; r < 16; ++r) { const float rl = __builtin_amdgcn_rcpf(al_l[crow(r, hi)]); float ss = 0.f;
#pragma unroll
    for (int d0 = 0; d0 < 4; ++d0) { const float v = o[d0][r] * rl; ss += v * v; }
    ss += __shfl_xor(ss, 1); ss += __shfl_xor(ss, 2); ss += __shfl_xor(ss, 4); ss += __shfl_xor(ss, 8); ss += __shfl_xor(ss, 16);
    if (r32 == 0) atomicAdd(w.ssq_a + rowb + crow(r, hi), ss); }
  FK_LAS unsigned char* st = lds + K_OFF + wid * STG_BYTES;
  stage_tile(st, o, al_l, r32, hi);
#pragma unroll
  for (int i = 0; i < 8; ++i) { const int q = lane + 64 * i, row = q >> 4, ch = q & 15; const int orow = rowb + row;
    const u32x4 v = *(const FK_LAS u32x4*)(st + row * STG_ROW + ch * 16); const u32x4 g = *(const u32x4*)(w.proj + (size_t)orow * PW + PC_GA + h * 128 + ch * 8);
    u32x4 y;
#pragma unroll
    for (int e = 0; e < 4; ++e) y[e] = cvt_pk_bf16(bflo(v[e]) * silu(bflo(g[e])), bfhi(v[e]) * silu(bfhi(g[e])));
    *(u32x4*)(w.y + (size_t)orow * DM + h * 128 + ch * 8) = y; }
}
__device__ __forceinline__ void unit2(FK_LAS unsigned char* lds, const W& w, int h, int q0, int) {
  int tid = threadIdx.x; asm volatile("" : "+v"(tid));
  const int wid = __builtin_amdgcn_readfirstlane(tid >> 6), lane = tid & 63, r32 = lane & 31, hi = lane >> 5;
  FK_LAS float* al_l = (FK_LAS float*)(lds + SCR_OFF + wid * 256);
  const char* Kg = (const char*)w.kf + (size_t)h * 128 * KB + wid * 3072; const char* Vg = (const char*)w.vf + (size_t)h * 128 * VB + wid * 2048;
  const unsigned lane16 = (unsigned)lane * 16u;
  constexpr int NT = S / 64;
#define FK_DMA_K(j, sl) do { const char* g_ = Kg + (size_t)(j) * KB + lane16; FK_LAS unsigned char* d_ = lds + K_OFF + (sl) * KB + wid * 3072; \
    _Pragma("unroll") for (int i_ = 0; i_ < 3; ++i_) __builtin_amdgcn_global_load_lds((const unsigned*)(g_ + i_ * 1024), (FK_LAS unsigned*)(d_ + i_ * 1024), 16, 0, 0); } while (0)
#define FK_DMA_V(j, sl) do { const char* g_ = Vg + (size_t)(j) * VB + lane16; FK_LAS unsigned char* d_ = lds + V_OFF + (sl) * VB + wid * 2048; \
    _Pragma("unroll") for (int i_ = 0; i_ < 2; ++i_) __builtin_amdgcn_global_load_lds((const unsigned*)(g_ + i_ * 1024), (FK_LAS unsigned*)(d_ + i_ * 1024), 16, 0, 0); } while (0)
#define FK_RESC(a) do { if (__any((a) < 1.f)) { if (hi == 0) al_l[r32] = (a); asm volatile("s_waitcnt lgkmcnt(0)" ::: "memory"); \
    _Pragma("unroll") for (int r_ = 0; r_ < 16; ++r_) { const float f_ = al_l[crow(r_, hi)]; _Pragma("unroll") for (int d_ = 0; d_ < 4; ++d_) o[d_][r_] *= f_; } } } while (0)
  FK_DMA_K(0, 0); FK_DMA_V(0, 0); FK_DMA_K(1, 1);
  bf16x8 qr[12];
  { const bf16_t* Qw = w.q + ((size_t)h * S + q0 + wid * 32 + r32) * 192 + hi * 8;
#pragma unroll
    for (int d0 = 0; d0 < 12; ++d0) qr[d0] = *(const bf16x8*)(Qw + d0 * 16); }
  float m_reg = -1e30f, l_reg = 0.f; f32x16 o[4];
#pragma unroll
  for (int d = 0; d < 4; ++d) o[d] = (f32x16){};
  f32x16 pA0, pA1, pB0, pB1; float alA, alB; bf16x8 pa0, pa1, pa2, pa3;
  const int vb0 = (int)(unsigned)(size_t)(lds + V_OFF) + v_rd_base(lane);
  int kb[4];
#pragma unroll
  for (int q_ = 0; q_ < 4; ++q_) kb[q_] = (int)(unsigned)(size_t)(lds + K_OFF) + r32 * 384 + (((2 * q_ + hi) ^ ((r32 >> 1) & 7)) << 4);
  asm volatile("s_waitcnt vmcnt(3)" ::: "memory"); __builtin_amdgcn_s_barrier();
  FK_DMA_K(2, 2); FK_DMA_V(1, 1);
  FK_QKT(pA0, pA1, 0); partialSM(pA0, pA1, m_reg, alA);
  int sk = 1, sv = 0;
  for (int j = 1; j < NT; j += 2) {
    asm volatile("s_waitcnt vmcnt(5)" ::: "memory"); __builtin_amdgcn_s_barrier();
    { const int fv = sv == 0 ? 2 : sv - 1; FK_DMA_K(j + 2 < NT ? j + 2 : NT - 1, sv); FK_DMA_V(j + 1 < NT ? j + 1 : NT - 1, fv); }
    FK_QKT(pB0, pB1, sk * KB);
    finishSM_a(pA0, pA1, alA, l_reg); __builtin_amdgcn_sched_barrier(0);
    { FK_PV_DECL; FK_PV_ISSUE(sv * VB); finishSM_b(pA0, pA1, pa0, pa1, pa2, pa3); FK_PV_REST(); } partialSM(pB0, pB1, m_reg, alB);
    FK_RESC(alB);
    sv = sk; sk = sk == 2 ? 0 : sk + 1;
    asm volatile("s_waitcnt vmcnt(5)" ::: "memory"); __builtin_amdgcn_s_barrier();
    if (j + 1 < NT) {
      { const int fv = sv == 0 ? 2 : sv - 1; FK_DMA_K(j + 3 < NT ? j + 3 : NT - 1, sv); FK_DMA_V(j + 2 < NT ? j + 2 : NT - 1, fv); }
      FK_QKT(pA0, pA1, sk * KB);
    }
    finishSM_a(pB0, pB1, alB, l_reg); __builtin_amdgcn_sched_barrier(0);
    { FK_PV_DECL; FK_PV_ISSUE(sv * VB); finishSM_b(pB0, pB1, pa0, pa1, pa2, pa3); FK_PV_REST(); }
    if (j + 1 < NT) { partialSM(pA0, pA1, m_reg, alA); FK_RESC(alA); }
    sv = sk; sk = sk == 2 ? 0 : sk + 1;
  }
  asm volatile("s_waitcnt vmcnt(0)" ::: "memory"); __builtin_amdgcn_s_barrier();
  epilogue(lds, w, h, q0, o, l_reg);
  __builtin_amdgcn_s_barrier();
#undef FK_DMA_K
#undef FK_DMA_V
#undef FK_RESC
}
__device__ __forceinline__ void epilogue_unused_marker() {}
#if 0
  const int rowb = q0 + wid * 32;
#pragma unroll
  for (int r = 0; r < 16; ++r) { const int orow = rowb + crow(r, hi); const float rl = __builtin_amdgcn_rcpf(al_l[crow(r, hi)]); float ss = 0.f;
    const bf16_t* gp = w.proj + (size_t)orow * PW + PC_GA + h * 128 + r32; bf16_t* yp = w.y + (size_t)orow * DM + h * 128 + r32;
    float g4[4];
#pragma unroll
    for (int d0 = 0; d0 < 4; ++d0) g4[d0] = bf2f(gp[d0 * 32]);
#pragma unroll
    for (int d0 = 0; d0 < 4; ++d0) { const float v = o[d0][r] * rl; ss += v * v; yp[d0 * 32] = (bf16_t)(cvt_pk_bf16(v * silu(g4[d0]), 0.f) & 0xffffu); }
    ss += __shfl_xor(ss, 1); ss += __shfl_xor(ss, 2); ss += __shfl_xor(ss, 4); ss += __shfl_xor(ss, 8); ss += __shfl_xor(ss, 16);
    if (r32 == 0) atomicAdd(w.ssq_a + orow, ss); }
#endif

}

namespace dil {
constexpr int WAVE_LDS = 16384;
constexpr size_t WS_DO0 = 4 * MiB, WS_DO1 = 36 * MiB, WS_DO2 = 174 * MiB, WS_LSE = 206 * MiB;
__device__ __forceinline__ int kswz(int row, int chunk) { return row * 256 + ((chunk ^ (row & 15)) << 4); }
__device__ __forceinline__ bf16_t* dopart(unsigned char* ws, int pat) { return (bf16_t*)(ws + (pat == 0 ? WS_DO0 : (pat == 1 ? WS_DO1 : WS_DO2))); }
constexpr int RING = 9;
__device__ __forceinline__ void wg_item(FK_LAS unsigned char* lds, const W& w, unsigned char* ws, int pat, int h, int c, int qbg, int wave, int lane, int skip) {
  const int r32 = lane & 31, hi = lane >> 5;
  FK_LAS float* al_l = (FK_LAS float*)(lds + RING * WAVE_LDS + wave * 256);
  const int d = pat == 0 ? 1 : (pat == 1 ? 4 : 16); const int L = S / d; const int J0 = 256 * qbg, j0 = J0 + 32 * wave;
  const float nad = -exp2f(-8.f * (float)(h + 1) / 16.f) * LOG2E * (float)d;
  const int kr = lane >> 4, kc = lane & 15;
  const size_t rstep = (size_t)4 * d * PW;
  const bf16_t* kvbase = w.proj + (size_t)c * PW + h * 128 + kc * 8;
  { const int p0 = J0 - 64 + 32 * wave;
    if (p0 >= 0 && p0 < L && !(skip & 8)) { u32x4 kreg[8], vreg[8]; const bf16_t* base = kvbase + (size_t)(d * (p0 + kr)) * PW; FK_LAS unsigned char* wl = lds + wave * WAVE_LDS;
#pragma unroll
      for (int i = 0; i < 8; ++i) { kreg[i] = *(const u32x4*)(base + i * rstep + PC_KB); vreg[i] = *(const u32x4*)(base + i * rstep + PC_VB); }
#pragma unroll
      for (int i = 0; i < 8; ++i) { const int row = kr + 4 * i; *(FK_LAS u32x4*)(wl + kswz(row, kc)) = kreg[i]; *(FK_LAS u32x4*)(wl + 8192 + v_img(row, kc * 8)) = vreg[i]; } } }
  bf16x8 qr[8];
  { const bf16_t* Qw = w.proj + (size_t)(c + d * (j0 + r32)) * PW + PC_QB + h * 128 + hi * 8;
#pragma unroll
    for (int d0 = 0; d0 < 8; ++d0) qr[d0] = *(const bf16x8*)(Qw + d0 * 16); }
  float m_reg = 0.f, l_reg = 0.f; f32x16 o[4]; bool started = false;
#pragma unroll
  for (int dd = 0; dd < 4; ++dd) o[dd] = (f32x16){};
#define FK_COOP(t_, KN, VN, OK) do { const int pn_ = J0 - 64 + 32 * (t_); OK = ((t_) < 12) && (pn_ < L) && !(skip & 8); \
    if (OK) { const bf16_t* b_ = kvbase + (size_t)(d * (pn_ + 4 * wave + kr)) * PW; KN = *(const u32x4*)(b_ + PC_KB); VN = *(const u32x4*)(b_ + PC_VB); } } while (0)
  u32x4 kn, vn, kn2, vn2; bool ld, ld2;
  FK_COOP(8, kn, vn, ld);
  __syncthreads();
#pragma unroll 1
  for (int sb = 0; sb < 5; ++sb) {
    FK_COOP(9 + sb, kn2, vn2, ld2);
    const int t = wave + sb; const int p0 = J0 - 64 + 32 * t;
    if (p0 >= 0 && p0 < L && !(skip & 4)) {
      FK_LAS unsigned char* wl = lds + (t % RING) * WAVE_LDS; const int vb0 = (int)(unsigned)(size_t)(wl + 8192) + v_rd_base(lane);
      f32x16 p = (f32x16){};
#pragma unroll
      for (int d0 = 0; d0 < 8; ++d0) { const bf16x8 kf = *(const FK_LAS bf16x8*)(wl + kswz(r32, 2 * d0 + hi)); p = __builtin_amdgcn_mfma_f32_32x32x16_bf16(kf, qr[d0], p, 0, 0, 0); }
      const float basef = (float)(32 * sb - 64 + 4 * hi - r32);
      if (sb == 0 || sb == 4) {
#pragma unroll
        for (int r = 0; r < 16; ++r) { const float tt = basef + (float)((r & 3) + 8 * (r >> 2)); p[r] = (__builtin_fabsf(tt) <= 64.f) ? fmaf(nad, __builtin_fabsf(tt), p[r]) : -INFINITY; }
      } else {
#pragma unroll
        for (int r = 0; r < 16; ++r) { const float tt = basef + (float)((r & 3) + 8 * (r >> 2)); p[r] = fmaf(nad, __builtin_fabsf(tt), p[r]); }
      }
      float pmax = p[0];
#pragma unroll
      for (int r = 1; r < 16; ++r) pmax = fmaxf(pmax, p[r]);
      { auto rr = __builtin_amdgcn_permlane32_swap(__float_as_uint(pmax), __float_as_uint(pmax), false, false); pmax = fmaxf(__uint_as_float(rr[0]), __uint_as_float(rr[1])); }
      if (!started) { m_reg = pmax; started = true; }
      else if (!__all(pmax - m_reg <= mla::THR2)) {
        const float mn = fmaxf(m_reg, pmax); const float alpha = __builtin_amdgcn_exp2f(m_reg - mn); m_reg = mn; l_reg *= alpha;
        if (hi == 0) al_l[r32] = alpha; asm volatile("s_waitcnt lgkmcnt(0)" ::: "memory");
#pragma unroll
        for (int r = 0; r < 16; ++r) { const float f = al_l[crow(r, hi)];
#pragma unroll
          for (int dd = 0; dd < 4; ++dd) o[dd][r] *= f; } }
      float ps = 0.f;
#pragma unroll
      for (int r = 0; r < 16; ++r) { p[r] = __builtin_amdgcn_exp2f(p[r] - m_reg); ps += p[r]; }
      { auto rr = __builtin_amdgcn_permlane32_swap(__float_as_uint(ps), __float_as_uint(ps), false, false); ps = __uint_as_float(rr[0]) + __uint_as_float(rr[1]); }
      l_reg += ps;
      bf16x8 pa0, pa1; FK_PK4(p, 0, pa0); FK_PK4(p, 8, pa1);
#define FK_DPV(D0) do { const s16x4 l0 = tr_read<v_rd_off(D0, 0, 0)>(vb0), h0 = tr_read<v_rd_off(D0, 0, 1)>(vb0), l1 = tr_read<v_rd_off(D0, 1, 0)>(vb0), h1 = tr_read<v_rd_off(D0, 1, 1)>(vb0); \
        asm volatile("s_waitcnt lgkmcnt(0)" ::: "memory"); __builtin_amdgcn_sched_barrier(0); \
        o[D0] = __builtin_amdgcn_mfma_f32_32x32x16_bf16(pa0, FK_PKV(l0, h0), o[D0], 0, 0, 0); o[D0] = __builtin_amdgcn_mfma_f32_32x32x16_bf16(pa1, FK_PKV(l1, h1), o[D0], 0, 0, 0); } while (0)
      if (!(skip & 2)) { FK_DPV(0); FK_DPV(1); FK_DPV(2); FK_DPV(3); }
#undef FK_DPV
    }
    if (ld) { FK_LAS unsigned char* wn = lds + ((8 + sb) % RING) * WAVE_LDS; const int row = 4 * wave + kr; *(FK_LAS u32x4*)(wn + kswz(row, kc)) = kn; *(FK_LAS u32x4*)(wn + 8192 + v_img(row, kc * 8)) = vn; }
    kn = kn2; vn = vn2; ld = ld2;
    __syncthreads();
  }
#undef FK_COOP
  if (skip & 1) return;
  if (hi == 0) al_l[r32] = l_reg; asm volatile("s_waitcnt lgkmcnt(0)" ::: "memory");
  bf16_t* dop = dopart(ws, pat); float* lse = (float*)(ws + WS_LSE) + (size_t)pat * S * 16;
  FK_LAS unsigned char* st = lds + wave * WAVE_LDS;
  stage_tile(st, o, al_l, r32, hi);
#pragma unroll
  for (int i = 0; i < 8; ++i) { const int q = lane + 64 * i, row = q >> 4, ch = q & 15;
    *(u32x4*)(dop + (size_t)(c + d * (j0 + row)) * 2048 + h * 128 + ch * 8) = *(const FK_LAS u32x4*)(st + row * STG_ROW + ch * 16); }
  if (hi == 0) lse[(size_t)(c + d * (j0 + r32)) * 16 + h] = m_reg + __builtin_amdgcn_logf(l_reg);
  asm volatile("s_waitcnt lgkmcnt(0)" ::: "memory");
}
__device__ __forceinline__ void merge_rows(const W& w, unsigned char* ws, int gw, int NGW, int lane) {
  const float* lse = (const float*)(ws + WS_LSE);
  for (int row = gw; row < S; row += NGW) {
    float ss = 0.f;
#pragma unroll
    for (int i = 0; i < 4; ++i) { const int ch = lane + 64 * i, h = ch >> 4; const size_t off = (size_t)row * 2048 + ch * 8;
      const float l0 = lse[(size_t)row * 16 + h], l1 = lse[(size_t)(S + row) * 16 + h], l2 = lse[(size_t)(2 * S + row) * 16 + h];
      const float mm = fmaxf(fmaxf(l0, l1), l2); float w0 = __builtin_amdgcn_exp2f(l0 - mm), w1 = __builtin_amdgcn_exp2f(l1 - mm), w2 = __builtin_amdgcn_exp2f(l2 - mm);
      const float inv = __builtin_amdgcn_rcpf(w0 + w1 + w2); w0 *= inv; w1 *= inv; w2 *= inv;
      const u32x4 a = *(const u32x4*)(dopart(ws, 0) + off), b = *(const u32x4*)(dopart(ws, 1) + off), cc = *(const u32x4*)(dopart(ws, 2) + off);
      const u32x4 g = *(const u32x4*)(w.proj + (size_t)row * PW + PC_GB + ch * 8);
      u32x4 o;
#pragma unroll
      for (int e = 0; e < 4; ++e) { const float v0 = w0 * bflo(a[e]) + w1 * bflo(b[e]) + w2 * bflo(cc[e]), v1 = w0 * bfhi(a[e]) + w1 * bfhi(b[e]) + w2 * bfhi(cc[e]);
        ss += v0 * v0 + v1 * v1; o[e] = cvt_pk_bf16(v0 * silu(bflo(g[e])), v1 * silu(bfhi(g[e]))); }
      *(u32x4*)(w.y + (size_t)row * DM + 2048 + ch * 8) = o; }
    ss = wave_sum(ss);
    if (lane == 0) w.ssq_b[row] = ss;
  }
}
}

#define XB_TMO      128
#define XB_XCNT(j)  (256  + 64 * (j))
#define XB_XSUB(j)  (1280 + 64 * (j))
#define XB_XGEN(j)  (2304 + 64 * (j))
#define XB_TOP      3328
#define XB_TOPGEN   3392
#define XCD_BAR_WORDS 3456
#define XB_SPIN_CAP (1u << 18)
constexpr size_t WS_BAR = 512 * 1024;
__device__ __forceinline__ unsigned xb_ld(unsigned* p)              { return __hip_atomic_load(p, __ATOMIC_RELAXED, __HIP_MEMORY_SCOPE_AGENT); }
__device__ __forceinline__ unsigned xb_add(unsigned* p, unsigned v) { return __hip_atomic_fetch_add(p, v, __ATOMIC_RELAXED, __HIP_MEMORY_SCOPE_AGENT); }
__device__ __forceinline__ unsigned xb_xcc_id() { return (unsigned)__builtin_amdgcn_s_getreg((3 << 11) | 20) & 0xFu; }
#define XB_SPIN(cond, bar) do { unsigned _sp = 0; while (cond) { __builtin_amdgcn_s_sleep(1); \
    if ((++_sp & 255u) == 0u) { if (xb_ld(&(bar)[XB_TMO])) break; if (_sp > XB_SPIN_CAP) { atomicAdd(&(bar)[XB_TMO], 1u); break; } } } } while (0)
struct XcdBarrier { unsigned* bar; unsigned x; volatile FK_LAS unsigned* st; };
__device__ __forceinline__ XcdBarrier xcd_barrier_post(unsigned* bar, volatile FK_LAS unsigned* st) {
  XcdBarrier b; b.bar = bar; b.x = xb_xcc_id(); b.st = st;
  if (threadIdx.x == 0) (void)xb_add(&bar[XB_XCNT(b.x)], 1u);
  return b;
}
__device__ __forceinline__ void xcd_barrier_complete(unsigned* bar, unsigned x, unsigned& nloc, unsigned& nx) {
  const unsigned G = gridDim.x * gridDim.y * gridDim.z;
  unsigned sum, cnt, mine, sp = 0u;
  for (;;) {
    sum = 0u; cnt = 0u; mine = 0u;
#pragma unroll
    for (unsigned j = 0; j < 16; ++j) { const unsigned c = xb_ld(&bar[XB_XCNT(j)]); sum += c; cnt += (c > 0u) ? 1u : 0u; mine = (j == x) ? c : mine; }
    if (sum == G) break;
    __builtin_amdgcn_s_sleep(1);
    if ((++sp & 255u) == 0u) { if (xb_ld(&bar[XB_TMO])) break; if (sp > XB_SPIN_CAP) { atomicAdd(&bar[XB_TMO], 1u); break; } }
  }
  nloc = mine > 0u ? mine : 1u; nx = cnt > 0u ? cnt : 1u;
}
__device__ __forceinline__ void xcd_barrier(const XcdBarrier& b) {
  asm volatile("s_waitcnt vmcnt(0)" ::: "memory");
  __syncthreads();
  if (threadIdx.x == 0) {
    unsigned* bar = b.bar;
    __builtin_amdgcn_s_waitcnt(0);
    unsigned nloc = b.st[0], nx = b.st[1];
    if (nloc == 0u) { xcd_barrier_complete(bar, b.x, nloc, nx); b.st[0] = nloc; b.st[1] = nx; }
    const unsigned old = xb_add(&bar[XB_XSUB(b.x)], 1u);
    const unsigned gen = old / nloc;
    if (old + 1u == (gen + 1u) * nloc) {
      __builtin_amdgcn_fence(__ATOMIC_RELEASE, "agent");
      asm volatile("s_waitcnt vmcnt(0)" ::: "memory");
      const unsigned og = xb_add(&bar[XB_TOP], 1u);
      const unsigned tg = og / nx;
      if (og + 1u == (tg + 1u) * nx) xb_add(&bar[XB_TOPGEN], 1u);
      else XB_SPIN(xb_ld(&bar[XB_TOPGEN]) == tg, bar);
      __builtin_amdgcn_fence(__ATOMIC_ACQUIRE, "agent");
      xb_add(&bar[XB_XGEN(b.x)], 1u);
      asm volatile("s_waitcnt vmcnt(0)" ::: "memory");
    } else {
      XB_SPIN(xb_ld(&bar[XB_XGEN(b.x)]) == gen, bar);
      __builtin_amdgcn_fence(__ATOMIC_ACQUIRE, "agent");
      asm volatile("s_waitcnt vmcnt(0)" ::: "memory");
    }
  }
  __syncthreads();
}

constexpr int LDS_BYTES = 151552;
struct Args { Ptrs P; int ph_lo, ph_hi; int dry, sub; };

__global__ void __launch_bounds__(512, 2) mega(Args a) {
  extern __shared__ __attribute__((aligned(16))) unsigned char lds_raw[];
  FK_LAS unsigned char* lds = (FK_LAS unsigned char*)lds_raw;
  const Ptrs& P = a.P;
  const int G = gridDim.x, bx = blockIdx.x; const int vcu = (G % 8 == 0) ? (bx % 8) * (G / 8) + bx / 8 : bx;
  const int tid = threadIdx.x, lane = tid & 63, wave = __builtin_amdgcn_readfirstlane(tid >> 6);
#ifndef FK_MLA_UNIT
#define FK_MLA_UNIT unit2
#endif
#ifndef FK_SUB_MASK
#define FK_SUB_MASK 15
#endif
#ifndef FK_PHASE_MASK
#define FK_PHASE_MASK 0x7f
#endif
#define IN(k) (((FK_PHASE_MASK >> (k)) & 1) && a.ph_lo <= (k) && (k) < a.ph_hi)
#ifndef FK_CG_SEAMS
#define FK_CG_SEAMS 0x01
#endif
#define SEAM(k) do { if (IN(k) && IN((k) + 1)) { if ((FK_CG_SEAMS >> (k)) & 1) cg::this_grid().sync(); else xcd_barrier(xbar); } } while (0)
  { volatile FK_LAS unsigned* st = (volatile FK_LAS unsigned*)(lds + LDS_BYTES - 64); if (tid < 2) st[tid] = 0u; __syncthreads(); }
  XcdBarrier xbar; xbar.bar = (unsigned*)(a.P.ws + WS_BAR); xbar.x = 0; xbar.st = nullptr;
  if (a.ph_lo == 0 && a.ph_hi > 1 && bx == 0) { unsigned* bw = (unsigned*)(a.P.ws + WS_BAR); for (int i = tid; i < XCD_BAR_WORDS; i += 512) bw[i] = 0u; }
#ifndef FK_DRY_PHASE
#define FK_DRY_PHASE (-1)
#endif
#ifndef FK_DRY_REPS
#define FK_DRY_REPS 1
#endif
#define RUN(k, ...) do { if (IN(k)) { const int dry = a.dry; __VA_ARGS__ } } while (0)
  RUN(0, { const W w = mkW(P.ws); prologue(P, w, lds, vcu, G); __syncthreads(); });
  SEAM(0);
  if (a.ph_lo == 0 && a.ph_hi > 1) xbar = xcd_barrier_post((unsigned*)(a.P.ws + WS_BAR), (volatile FK_LAS unsigned*)(lds + LDS_BYTES - 64));
  RUN(1, { W w = mkW(P.ws); if (dry) { w.ssq_q = w.dummy; w.ssq_kv = w.dummy; } pg8::Gemm g{w.xb, w.win, DM, DM, DM}; pg8::StaticOrder so; so.init(S, N1, G, bx);
    Epi1 E{w.proj, w.rs_x, w.ssq_q, w.ssq_kv, w.tab, w.kf}; pg8::gemm_phase<Epi1>(lds, g, so, E);
    constexpr int FULL = (S / 256) * (N1 / 256) % 256;
    if (G == 256 && bx >= FULL) { pg8::Gemm g2{w.pb, w.wple, 256, 256, 256}; pg8::StaticOrder so2; so2.init(S, DM, G - FULL, bx - FULL); EpiPle E2{w.ple, DM}; pg8::gemm_phase<EpiPle>(lds, g2, so2, E2); } });
  SEAM(1);
  RUN(2, { W w = mkW(P.ws);
    if (G == 256) {
      const bool lo = vcu < 128;
      if (FK_SUB_MASK & a.sub & 1) { pg8::Gemm g{w.proj + PC_CQ, w.wuq, PW, 1024, 1024}; pg8::ListOrder so{lo ? 2 * vcu : 128 + vcu, lo ? 2 : 1, 12}; Epi2a E{w.q, w.ssq_q, w.tab}; pg8::gemm_phase<Epi2a, pg8::ListOrder>(lds, g, so, E); }
      if (FK_SUB_MASK & a.sub & 2) { pg8::Gemm g{w.proj + PC_CKV, w.wukv, PW, 512, 512}; pg8::ListOrder so{lo ? vcu : 128 + 3 * (vcu - 128), lo ? 1 : 3, 16}; Epi2b E{w.kf, w.vf, w.ssq_kv}; pg8::gemm_phase<Epi2b, pg8::ListOrder>(lds, g, so, E); }
    } else {
      if (FK_SUB_MASK & a.sub & 1) { pg8::Gemm g{w.proj + PC_CQ, w.wuq, PW, 1024, 1024}; pg8::StaticOrder so; so.init(S, 3072, G, bx); Epi2a E{w.q, w.ssq_q, w.tab}; pg8::gemm_phase<Epi2a>(lds, g, so, E); }
      if (FK_SUB_MASK & a.sub & 2) { pg8::Gemm g{w.proj + PC_CKV, w.wukv, PW, 512, 512}; pg8::StaticOrder so; so.init(S, 4096, G, bx); Epi2b E{w.kf, w.vf, w.ssq_kv}; pg8::gemm_phase<Epi2b>(lds, g, so, E); }
    }
    if (G != 256) { pg8::Gemm g{w.pb, w.wple, 256, 256, 256}; pg8::StaticOrder so; so.init(S, DM, G, bx); EpiPle E{w.ple, DM}; pg8::gemm_phase<EpiPle>(lds, g, so, E); }
    if (FK_SUB_MASK & a.sub & 8) for (int it = vcu; it < 1536; it += G) { const int pat = it >> 9, idx = it & 511;
      const int dsh = pat * 2, ng = 32 >> dsh; const int qbg = idx & (ng - 1), cls = (idx >> (5 - dsh)) & ((1 << dsh) - 1), h = idx >> 5;
      dil::wg_item(lds, w, P.ws, pat, h, cls, qbg, wave, lane, dry ? (a.sub >> 8) : 0); }
    __syncthreads(); });
  SEAM(2);
  RUN(3, { W w = mkW(P.ws); if (dry) { w.ssq_a = w.dummy; w.ssq_b = w.dummy; } if (a.sub & 16) dil::merge_rows(w, P.ws, vcu * 8 + wave, G * 8, lane);
    if (a.sub & 32) for (int it = vcu; it < 512; it += G) mla::FK_MLA_UNIT(lds, w, it >> 5, (it & 31) * 256, 0); });
  SEAM(3);
  RUN(4, { W w = mkW(P.ws); if (dry) w.ssq_x1 = w.dummy; pg8::Gemm g{w.y, w.wout, DM, DM, DM}; pg8::StaticOrder so; so.init(S, DM, G, bx);
    Epi4 E{P.x, P.out, w.xb, w.ssq_a, w.ssq_b, w.ssq_x1}; pg8::gemm_phase<Epi4>(lds, g, so, E); });
  SEAM(4);
  RUN(5, { W w = mkW(P.ws); if (dry) w.ssq_x2 = w.dummy; pg8::Gemm g{w.xb, w.wpg, DM, DM, DM}; pg8::StaticOrder so; so.init(S, DM, G, bx);
    Epi5 E{w.xb, w.y, w.ple, w.ssq_x1, w.ssq_x2}; pg8::gemm_phase<Epi5>(lds, g, so, E); });
  SEAM(5);
  RUN(6, { const W w = mkW(P.ws); const int gt = vcu * 512 + tid, NGT = G * 512; f32x4* ow = dry ? (f32x4*)(P.ws + WS_Q) : (f32x4*)P.out;
    for (int i = gt; i < S * DM / 8; i += NGT) { const int row = i >> 9, c8 = i & 511; const float rs = rsqrtf(w.ssq_x2[row] * (1.f / 4096.f) + EPS);
      const f32x4 ga = ((const f32x4*)P.g_fin)[2 * c8], gb = ((const f32x4*)P.g_fin)[2 * c8 + 1]; const u32x4 xv = ((const u32x4*)w.y)[i];
      f32x4 a, b; a[0] = bflo(xv.x); a[1] = bfhi(xv.x); a[2] = bflo(xv.y); a[3] = bfhi(xv.y); b[0] = bflo(xv.z); b[1] = bfhi(xv.z); b[2] = bflo(xv.w); b[3] = bfhi(xv.w);
      ow[2 * i] = a * rs * ga; ow[2 * i + 1] = b * rs * gb; } });
#undef RUN
#undef IN
#undef SEAM
}

static inline Ptrs mkPtrs(void* const* d_in, void* d_out, void* d_ws) {
  Ptrs P{};
  P.x = (const float*)d_in[0]; P.p = (const float*)d_in[1]; P.pos = (const int*)d_in[2]; P.g_mix = (const float*)d_in[3]; P.w_in = (const float*)d_in[4];
  P.g_q = (const float*)d_in[5]; P.w_uq = (const float*)d_in[6]; P.g_kv = (const float*)d_in[7]; P.w_ukv = (const float*)d_in[8]; P.g_oa = (const float*)d_in[9];
  P.g_ob = (const float*)d_in[10]; P.w_out = (const float*)d_in[11]; P.w_ple = (const float*)d_in[12]; P.g_ple = (const float*)d_in[13]; P.w_pg = (const float*)d_in[14];
  P.g_fin = (const float*)d_in[15]; P.out = (float*)d_out; P.ws = (unsigned char*)d_ws;
  return P;
}
}


#ifndef FK_NLAUNCH
#define FK_NLAUNCH 1
#endif
extern "C" void kernel_launch(void* const* d_in, const int* in_sizes, int n_in, void* d_out, int out_size, void* d_ws, size_t ws_size, hipStream_t stream) {
  static int grid = 0;
  if (grid == 0) {
    if (n_in != 16 || out_size != fk::S * fk::DM || ws_size < fk::WS_END) { fprintf(stderr, "kernel_launch: unexpected shapes n_in %d out %d ws %zu\n", n_in, out_size, ws_size); grid = -1; return; }
    int dev = 0, cus = 0, per_cu = 0;
    (void)hipGetDevice(&dev); (void)hipDeviceGetAttribute(&cus, hipDeviceAttributeMultiprocessorCount, dev);
    if (hipFuncSetAttribute((const void*)fk::mega, hipFuncAttributeMaxDynamicSharedMemorySize, fk::LDS_BYTES) != hipSuccess) { fprintf(stderr, "kernel_launch: hipFuncSetAttribute failed\n"); grid = -1; return; }
    if (hipOccupancyMaxActiveBlocksPerMultiprocessor(&per_cu, (const void*)fk::mega, 512, fk::LDS_BYTES) != hipSuccess || per_cu < 1) { fprintf(stderr, "kernel_launch: occupancy query says %d workgroups per CU; nothing launched\n", per_cu); grid = -1; return; }
    grid = cus * 1;
  }
  if (grid < 0) return;
  fk::Args a{}; a.P = fk::mkPtrs(d_in, d_out, d_ws); a.sub = 63;
#if FK_NLAUNCH == 1
  a.ph_lo = 0; a.ph_hi = 7; a.dry = 0;
  void* args[] = {&a};
  hipError_t e = hipLaunchCooperativeKernel((const void*)fk::mega, dim3(grid), dim3(512), args, fk::LDS_BYTES, stream);
  if (e != hipSuccess) fprintf(stderr, "cooperative launch failed: %s (grid %d)\n", hipGetErrorString(e), grid);
#ifdef FK_PROBE_PHASE
  for (int r_ = 0; r_ < FK_PROBE_REPS; ++r_) { a.ph_lo = FK_PROBE_PHASE; a.ph_hi = FK_PROBE_PHASE + 1; a.dry = 1; a.sub = FK_PROBE_SUB; hipLaunchKernelGGL(fk::mega, dim3(grid), dim3(512), fk::LDS_BYTES, stream, a); }
#endif
#else
  for (int ph = 0; ph < 7; ++ph) { a.ph_lo = ph; a.ph_hi = ph + 1; a.dry = 0; hipLaunchKernelGGL(fk::mega, dim3(grid), dim3(512), fk::LDS_BYTES, stream, a); }
#endif
}
```

```cpp
#include <hip/hip_runtime.h>
#include <cstdio>
#include <hip/hip_cooperative_groups.h>
#ifndef FK_EPI_FENCE
#define FK_EPI_FENCE 4
#endif
namespace fk {
namespace cg = cooperative_groups;
#define FK_LAS __attribute__((address_space(3)))
typedef unsigned short bf16_t;
typedef short bf16x8 __attribute__((ext_vector_type(8)));
typedef short s16x4 __attribute__((ext_vector_type(4)));
typedef float f32x4 __attribute__((ext_vector_type(4)));
typedef float f32x2 __attribute__((ext_vector_type(2)));
typedef float f32x16 __attribute__((ext_vector_type(16)));
typedef unsigned u32x4 __attribute__((ext_vector_type(4)));
typedef unsigned u32x2 __attribute__((ext_vector_type(2)));

constexpr int S = 8192, DM = 4096, INW = 11840, NH = 16;
constexpr int N1 = 12032;
constexpr int PW = 11776;
constexpr int PC_CQ = 0, PC_CKV = 1024, PC_GA = 1536, PC_QB = 3584, PC_KB = 5632, PC_VB = 7680, PC_GB = 9728;
constexpr float EPS = 1e-6f;
constexpr float LOG2E = 1.4426950408889634f;
constexpr float QSCALE = 0.07216878364870322f * LOG2E;
constexpr float DSCALE = 0.08838834764831845f * LOG2E;

constexpr size_t MiB = 1u << 20;
constexpr size_t WS_CTL = 0;
constexpr size_t WS_TAB = 1 * MiB;
constexpr size_t WS_WIN = 4 * MiB;
constexpr size_t WS_WUQ = 98 * MiB;
constexpr size_t WS_WUKV = 104 * MiB;
constexpr size_t WS_WOUT = 108 * MiB;
constexpr size_t WS_WPLE = 140 * MiB;
constexpr size_t WS_WPG = 142 * MiB;
constexpr size_t WS_XB = 174 * MiB;
constexpr size_t WS_PB = 238 * MiB;
constexpr size_t WS_PROJ = 242 * MiB;
constexpr size_t WS_Q = 426 * MiB;
constexpr size_t WS_KF = 474 * MiB;
constexpr size_t WS_VF = 522 * MiB;
constexpr size_t WS_Y = 554 * MiB;
constexpr size_t WS_PLE = 618 * MiB;
constexpr size_t WS_END = 682 * MiB;

struct Ptrs {
  const float *x, *p; const int* pos;
  const float *g_mix, *w_in, *g_q, *w_uq, *g_kv, *w_ukv, *g_oa, *g_ob, *w_out, *w_ple, *g_ple, *w_pg, *g_fin;
  float* out; unsigned char* ws;
};
struct W {
  float *ssq_q, *ssq_kv, *ssq_a, *ssq_b, *ssq_x1, *ssq_x2, *rs_x; f32x2* tab;
  bf16_t *win, *wuq, *wukv, *wout, *wple, *wpg, *xb, *pb, *proj, *q, *kf, *vf, *y, *ple; float* dummy;
};
__device__ __forceinline__ W mkW(unsigned char* ws) {
  W w; float* c = (float*)(ws + WS_CTL);
  w.ssq_q = c; w.ssq_kv = c + S; w.ssq_a = c + 2 * S; w.ssq_b = c + 3 * S; w.ssq_x1 = c + 4 * S; w.ssq_x2 = c + 5 * S; w.rs_x = c + 6 * S;
  w.tab = (f32x2*)(ws + WS_TAB);
  w.win = (bf16_t*)(ws + WS_WIN); w.wuq = (bf16_t*)(ws + WS_WUQ); w.wukv = (bf16_t*)(ws + WS_WUKV); w.wout = (bf16_t*)(ws + WS_WOUT);
  w.wple = (bf16_t*)(ws + WS_WPLE); w.wpg = (bf16_t*)(ws + WS_WPG); w.xb = (bf16_t*)(ws + WS_XB); w.pb = (bf16_t*)(ws + WS_PB);
  w.proj = (bf16_t*)(ws + WS_PROJ); w.q = (bf16_t*)(ws + WS_Q); w.kf = (bf16_t*)(ws + WS_KF); w.vf = (bf16_t*)(ws + WS_VF);
  w.y = (bf16_t*)(ws + WS_Y); w.ple = (bf16_t*)(ws + WS_PLE); w.dummy = c + 7 * S;
  return w;
}

__device__ __forceinline__ unsigned cvt_pk_bf16(float lo, float hi) { unsigned r; asm volatile("v_cvt_pk_bf16_f32 %0, %1, %2" : "=v"(r) : "v"(lo), "v"(hi)); return r; }
__device__ __forceinline__ float bf2f(unsigned short b) { return __uint_as_float(((unsigned)b) << 16); }
__device__ __forceinline__ float bflo(unsigned w) { return __uint_as_float(w << 16); }
__device__ __forceinline__ float bfhi(unsigned w) { return __uint_as_float(w & 0xffff0000u); }
__device__ __forceinline__ float wave_sum(float v) {
#pragma unroll
  for (int o = 1; o < 64; o <<= 1) v += __shfl_xor(v, o);
  return v;
}
__device__ __forceinline__ float silu(float g) { return g * __builtin_amdgcn_rcpf(1.f + __builtin_amdgcn_exp2f(-LOG2E * g)); }
__device__ __forceinline__ int crow(int r, int hi) { return (r & 3) + 8 * (r >> 2) + 4 * hi; }

__device__ __forceinline__ int k_img(int r, int c) { return r * 384 + ((c ^ ((r >> 1) & 7)) << 4); }
__device__ __forceinline__ int v_img(int k, int c) { const int kk = (k & ~0xC) | ((k & 4) << 1) | ((k & 8) >> 1); return ((kk >> 3) * 4 + (c >> 5)) * 512 + ((kk & 7) * 32 + (c & 31)) * 2; }
__device__ __forceinline__ int v_rd_base(int lane) { return ((lane & 3) << 3) | (((lane >> 2) & 3) << 6) | (((lane >> 4) & 1) << 5) | (((lane >> 5) & 1) << 8); }
constexpr int v_rd_off(int d0, int ks, int half) { return d0 * 512 + ks * 4096 + half * 2048; }
template <int OFF> __device__ __forceinline__ s16x4 tr_read(int vb) {
  s16x4 r; asm volatile("ds_read_b64_tr_b16 %0, %1 offset:%2" : "=&v"(r) : "v"(vb), "i"(OFF) : "memory"); return r;
}

namespace pg8 {
constexpr int BM = 256, BK = 64, HALF = 128, HTB = HALF * BK * 2, STAGE_BYTES = 8 * HTB, NXCD = 8, WGM = 8;
__device__ __forceinline__ int lds_byte(int r, int c) { const int st = (r >> 4) * 2 + (c >> 5), rr = r & 15, cc = c & 31, ob = rr * 64 + cc * 2; return st * 1024 + (ob ^ (((ob >> 9) & 1) << 5)); }
__device__ __forceinline__ void stage_rc(int b, int& R, int& C) { const int st = b / 1024, sb = b % 1024, swz = sb ^ (((sb >> 9) & 1) << 5); R = (st >> 1) * 16 + swz / 64; C = (st & 1) * 32 + (swz % 64) / 2; }
__device__ __forceinline__ int perm32(int rho) { const int n = rho >> 4, i = rho & 15; return 8 * (i >> 2) + 4 * n + (i & 3); }
struct Unit { int pm, pn; };
struct Gemm { const bf16_t* A; const bf16_t* Bt; int lda, ldb, K; };
struct StaticOrder {
  int nM, nN, nwg, G, c;
  __device__ void init(int M, int N, int G_, int c_) { nM = M / BM; nN = N / BM; nwg = nM * nN; G = G_; c = c_; }
  __device__ bool next(int i, Unit& u) const {
    const long L = (long)i * G + c; if (L >= nwg) return false;
    int wgid = (int)L; { const int q = nwg / NXCD, r = nwg % NXCD, xcd = wgid % NXCD, off = wgid / NXCD; wgid = (xcd < r ? xcd * (q + 1) : r * (q + 1) + (xcd - r) * q) + off; }
    const int nig = WGM * nN, gid = wgid / nig, fm = gid * WGM, gsz = (nM - fm) < WGM ? (nM - fm) : WGM;
    u.pm = fm + ((wgid % nig) % gsz); u.pn = (wgid % nig) / gsz; return true;
  }
};
struct ListOrder {
  int base, count, nN;
  __device__ bool next(int i, Unit& u) const { if (i >= count) return false; const int L = base + i; u.pm = L / nN; u.pn = L - u.pm * nN; return true; }
};
template <class Epi, class Ord = StaticOrder, bool ALIGN_EPI = true, bool SP2 = true>
__device__ __forceinline__ void gemm_phase(FK_LAS unsigned char* lds, const Gemm g, const Ord& S, const Epi& E) {
  const int tid = threadIdx.x, wid = __builtin_amdgcn_readfirstlane(tid >> 6), lane = tid & 63, wr = wid >> 2, wc = wid & 3, fr = lane & 15, fq = lane >> 4;
  const int K = g.K; int nt = K / BK; asm volatile("" : "+s"(nt));
  unsigned voffA[2], voffB[2];
#pragma unroll
  for (int i = 0; i < 2; ++i) { int R, C; stage_rc(tid * 16 + i * 8192, R, C); const int Rb = Epi::PERM ? ((R & ~31) + perm32(R & 31)) : R;
    voffA[i] = (unsigned)(R * g.lda + C) * 2u; voffB[i] = (unsigned)(Rb * g.ldb + C) * 2u; }
  const size_t kstep = (size_t)(BK * 2);
  const size_t hstepA = (size_t)HALF * g.lda * 2, hstepB = (size_t)HALF * g.ldb * 2;
  const size_t tstepA = 2 * hstepA, tstepB = 2 * hstepB;
  const unsigned ldsw = (unsigned)wid * 1024u;
  const int aoff = lds_byte(wr * 64 + fr, fq * 8), boff = lds_byte(wc * 32 + fr, fq * 8);
#define PG8_SA(b, h) (((b) * 2 + (h)) * HTB)
#define PG8_SB(b, h) ((4 + (b) * 2 + (h)) * HTB)
#define PG8_STAGE(bufoff, gbase, voff) do { _Pragma("unroll") for (int _i = 0; _i < 2; ++_i) \
    __builtin_amdgcn_global_load_lds((const unsigned*)((const char*)(gbase) + (voff)[_i]), (FK_LAS unsigned*)(lds + (bufoff) + ldsw + _i * 8192), 16, 0, 0); } while (0)
#define PG8_LDA(dst, b, h) do { _Pragma("unroll") for (int m = 0; m < 4; ++m) _Pragma("unroll") for (int k = 0; k < 2; ++k) dst[m][k] = *(const FK_LAS bf16x8*)(lds + PG8_SA(b, h) + aoff + m * 2048 + k * 1024); } while (0)
#define PG8_LDB(dst, b, h) do { _Pragma("unroll") for (int n = 0; n < 2; ++n) _Pragma("unroll") for (int k = 0; k < 2; ++k) dst[n][k] = *(const FK_LAS bf16x8*)(lds + PG8_SB(b, h) + boff + n * 2048 + k * 1024); } while (0)
#define PG8_MMA(ai, bj, At, Bt) do { __builtin_amdgcn_s_setprio(1); _Pragma("unroll") for (int m = 0; m < 4; ++m) _Pragma("unroll") for (int n = 0; n < 2; ++n) _Pragma("unroll") for (int k = 0; k < 2; ++k) \
    acc[ai][bj][m][n] = __builtin_amdgcn_mfma_f32_16x16x32_bf16(Bt[n][k], At[m][k], acc[ai][bj][m][n], 0, 0, 0); __builtin_amdgcn_s_setprio(0); } while (0)
#define PG8_WAIT_V(n) asm volatile("s_waitcnt vmcnt(" #n ")" ::: "memory")
#define PG8_WAIT_L(n) asm volatile("s_waitcnt lgkmcnt(" #n ")" ::: "memory")
#define PG8_BAR __builtin_amdgcn_s_barrier()
#define PG8_SCHED __builtin_amdgcn_sched_barrier(0)
  Unit cur, nxt; int ui = 0;
  if (!S.next(0, cur)) return;
  f32x4 acc[2][2][4][2];
#pragma unroll
  for (int a = 0; a < 2; ++a)
#pragma unroll
    for (int b = 0; b < 2; ++b)
#pragma unroll
      for (int m = 0; m < 4; ++m)
#pragma unroll
        for (int n = 0; n < 2; ++n) acc[a][b][m][n] = (f32x4){0.f, 0.f, 0.f, 0.f};
  bf16x8 At[4][2], B0[2][2], B1[2][2];
  const char* cA = (const char*)g.A + (size_t)cur.pm * tstepA; const char* cB = (const char*)g.Bt + (size_t)cur.pn * tstepB;
  if constexpr (Epi::BEGIN) E.begin(cur, 0, lds, tid);
  if constexpr (SP2) {
    PG8_STAGE(PG8_SB(0, 0), cB, voffB); PG8_STAGE(PG8_SB(0, 1), cB + hstepB, voffB); PG8_STAGE(PG8_SA(0, 0), cA, voffA); PG8_STAGE(PG8_SA(0, 1), cA + hstepA, voffA);
    if (wr == 1) PG8_BAR;
    PG8_WAIT_V(2); PG8_BAR;
    PG8_STAGE(PG8_SB(1, 0), cB + kstep, voffB); PG8_STAGE(PG8_SA(1, 0), cA + kstep, voffA); PG8_STAGE(PG8_SB(1, 1), cB + hstepB + kstep, voffB);
    PG8_WAIT_V(6); PG8_BAR;
  } else {
    PG8_STAGE(PG8_SB(0, 0), cB, voffB); PG8_STAGE(PG8_SA(0, 0), cA, voffA); PG8_STAGE(PG8_SB(0, 1), cB + hstepB, voffB); PG8_STAGE(PG8_SA(0, 1), cA + hstepA, voffA);
    if (wr == 1) PG8_BAR;
    PG8_WAIT_V(4); PG8_BAR;
    PG8_STAGE(PG8_SB(1, 0), cB + kstep, voffB); PG8_STAGE(PG8_SA(1, 0), cA + kstep, voffA); PG8_STAGE(PG8_SB(1, 1), cB + hstepB + kstep, voffB);
    PG8_WAIT_V(6); PG8_BAR;
  }
  for (;;) {
    const bool has_next = S.next(ui + 1, nxt);
    const char* nA = has_next ? (const char*)g.A + (size_t)nxt.pm * tstepA : cA; const char* nB = has_next ? (const char*)g.Bt + (size_t)nxt.pn * tstepB : cB;
    for (int t = 0; t < nt; t += 2) {
      const bool last = (t == nt - 2);
      const char* a1 = cA + (size_t)(t + 1) * kstep;
      const char* a2 = last ? nA : cA + (size_t)(t + 2) * kstep; const char* b2 = last ? nB : cB + (size_t)(t + 2) * kstep;
      const char* a3 = a2 + kstep; const char* b3 = b2 + kstep;
      if constexpr (Epi::MIDK) { if (t == nt / 2) E.mid(acc, ui & 1, lds, wr, fr); }
      if constexpr (SP2) {
        PG8_LDB(B0, 0, 0); PG8_LDB(B1, 0, 1); PG8_SCHED; PG8_LDA(At, 0, 0); PG8_STAGE(PG8_SA(1, 1), a1 + hstepA, voffA);
        PG8_WAIT_V(8); PG8_WAIT_L(0); PG8_BAR; PG8_MMA(0, 0, At, B0); PG8_MMA(0, 1, At, B1); PG8_BAR; PG8_SCHED;
        PG8_LDA(At, 0, 1); PG8_STAGE(PG8_SB(0, 0), b2, voffB); PG8_STAGE(PG8_SB(0, 1), b2 + hstepB, voffB); PG8_STAGE(PG8_SA(0, 0), a2, voffA);
        PG8_WAIT_V(8); PG8_WAIT_L(0); PG8_BAR; PG8_MMA(1, 0, At, B0); PG8_MMA(1, 1, At, B1); PG8_BAR; PG8_SCHED;
        PG8_LDB(B0, 1, 0); PG8_LDB(B1, 1, 1); PG8_SCHED; PG8_LDA(At, 1, 0); PG8_STAGE(PG8_SA(0, 1), a2 + hstepA, voffA);
        PG8_WAIT_V(8); PG8_WAIT_L(0); PG8_BAR; PG8_MMA(0, 0, At, B0); PG8_MMA(0, 1, At, B1); PG8_BAR; PG8_SCHED;
        PG8_LDA(At, 1, 1); PG8_STAGE(PG8_SB(1, 0), b3, voffB); PG8_STAGE(PG8_SB(1, 1), b3 + hstepB, voffB); PG8_STAGE(PG8_SA(1, 0), a3, voffA);
        PG8_WAIT_V(8); PG8_WAIT_L(0); PG8_BAR; PG8_MMA(1, 0, At, B0); PG8_MMA(1, 1, At, B1); PG8_BAR; PG8_SCHED;
      } else {
        PG8_LDB(B0, 0, 0); PG8_SCHED; PG8_LDA(At, 0, 0); PG8_STAGE(PG8_SA(1, 1), a1 + hstepA, voffA);
        PG8_WAIT_L(8); PG8_BAR; PG8_WAIT_L(0); PG8_MMA(0, 0, At, B0); PG8_BAR; PG8_SCHED;
        PG8_LDB(B1, 0, 1); PG8_STAGE(PG8_SB(0, 0), b2, voffB);
        PG8_BAR; PG8_WAIT_L(0); PG8_MMA(0, 1, At, B1); PG8_BAR;
        PG8_LDA(At, 0, 1); PG8_STAGE(PG8_SA(0, 0), a2, voffA);
        PG8_BAR; PG8_WAIT_L(0); PG8_MMA(1, 0, At, B0); PG8_BAR; PG8_SCHED;
        PG8_STAGE(PG8_SB(0, 1), b2 + hstepB, voffB);
        PG8_WAIT_V(6); PG8_BAR; PG8_MMA(1, 1, At, B1); PG8_BAR;
        PG8_LDB(B0, 1, 0); PG8_SCHED; PG8_LDA(At, 1, 0); PG8_STAGE(PG8_SA(0, 1), a2 + hstepA, voffA);
        PG8_WAIT_L(8); PG8_BAR; PG8_WAIT_L(0); PG8_MMA(0, 0, At, B0); PG8_BAR; PG8_SCHED;
        PG8_LDB(B1, 1, 1); PG8_STAGE(PG8_SB(1, 0), b3, voffB);
        PG8_BAR; PG8_WAIT_L(0); PG8_MMA(0, 1, At, B1); PG8_BAR;
        PG8_LDA(At, 1, 1); PG8_STAGE(PG8_SA(1, 0), a3, voffA);
        PG8_BAR; PG8_WAIT_L(0); PG8_MMA(1, 0, At, B0); PG8_BAR; PG8_SCHED;
        PG8_STAGE(PG8_SB(1, 1), b3 + hstepB, voffB);
        PG8_WAIT_V(6); PG8_BAR; PG8_MMA(1, 1, At, B1); PG8_BAR;
      }
    }
    if constexpr (ALIGN_EPI) { if (wr == 0) PG8_BAR; }
    if constexpr (Epi::BEGIN) E.epi(acc, cur, ui & 1, lds, wr, wc, fr, fq); else E(acc, cur, wr, wc, fr, fq);
    if (!has_next) break;
#pragma unroll
    for (int a = 0; a < 2; ++a)
#pragma unroll
      for (int b = 0; b < 2; ++b)
#pragma unroll
        for (int m = 0; m < 4; ++m)
#pragma unroll
          for (int n = 0; n < 2; ++n) acc[a][b][m][n] = (f32x4){0.f, 0.f, 0.f, 0.f};
    cur = nxt; cA = nA; cB = nB; ++ui;
    if constexpr (Epi::BEGIN) E.begin(cur, ui & 1, lds, tid);
    if constexpr (ALIGN_EPI) { if (wr == 1) PG8_BAR; }
  }
  PG8_WAIT_V(0);
  if constexpr (!ALIGN_EPI) { if (wr == 0) PG8_BAR; }
  PG8_BAR;
#undef PG8_SA
#undef PG8_SB
#undef PG8_STAGE
#undef PG8_LDA
#undef PG8_LDB
#undef PG8_MMA
#undef PG8_WAIT_V
#undef PG8_WAIT_L
#undef PG8_BAR
#undef PG8_SCHED
}
}

typedef f32x4 Acc[2][2][4][2];
__device__ __forceinline__ u32x4 pack8(f32x4 a, f32x4 b) { u32x4 w; w.x = cvt_pk_bf16(a[0], a[1]); w.y = cvt_pk_bf16(a[2], a[3]); w.z = cvt_pk_bf16(b[0], b[1]); w.w = cvt_pk_bf16(b[2], b[3]); return w; }
__device__ __forceinline__ void rope8(f32x4& v0, f32x4& v1, const f32x2* tabrow, int i0) {
  const f32x2 c0 = tabrow[i0], c1 = tabrow[i0 + 1], c2 = tabrow[i0 + 2], c3 = tabrow[i0 + 3];
  const f32x4 a = v0, b = v1;
  v0[0] = a[0] * c0.x - a[1] * c0.y; v0[1] = a[0] * c0.y + a[1] * c0.x; v0[2] = a[2] * c1.x - a[3] * c1.y; v0[3] = a[2] * c1.y + a[3] * c1.x;
  v1[0] = b[0] * c2.x - b[1] * c2.y; v1[1] = b[0] * c2.y + b[1] * c2.x; v1[2] = b[2] * c3.x - b[3] * c3.y; v1[3] = b[2] * c3.y + b[3] * c3.x;
}
struct Epi1 {
  static constexpr bool PERM = true, MIDK = false, BEGIN = false;
  bf16_t* proj; const float* rsx; float* ssq_q; float* ssq_kv; const f32x2* tab; bf16_t* kf;
  __device__ __forceinline__ void mid(Acc&, int, FK_LAS unsigned char*, int, int) const {}
  __device__ __forceinline__ void operator()(const Acc& acc, const pg8::Unit& u, int wr, int wc, int fr, int fq) const {
    const int row0 = u.pm * 256 + wr * 64 + fr;
    if (u.pn < 46) {
      const int col0 = u.pn * 256 + wc * 32 + 8 * fq; const float cs = (u.pn >= PC_QB / 256 && u.pn < PC_KB / 256) ? DSCALE : 1.f;
#pragma unroll
      for (int ai = 0; ai < 2; ++ai)
#pragma unroll
        for (int m = 0; m < 4; ++m) { const int row = row0 + ai * 128 + m * 16; const float rs = rsx[row] * cs; float ss = 0.f;
          bf16_t* rowp = proj + (size_t)row * PW + col0;
#pragma unroll
          for (int bj = 0; bj < 2; ++bj) { const f32x4 v0 = acc[ai][bj][m][0] * rs, v1 = acc[ai][bj][m][1] * rs;
            ss += (v0[0] * v0[0] + v0[1] * v0[1]) + (v0[2] * v0[2] + v0[3] * v0[3]) + (v1[0] * v1[0] + v1[1] * v1[1]) + (v1[2] * v1[2] + v1[3] * v1[3]);
            *(u32x4*)(rowp + bj * 128) = pack8(v0, v1); }
          if (u.pn < 6) { ss += __shfl_xor(ss, 16); ss += __shfl_xor(ss, 32); if (fq == 0) atomicAdd((u.pn < 4 ? ssq_q : ssq_kv) + row, ss); } }
    } else if (wc < 2) {
#pragma unroll
      for (int ai = 0; ai < 2; ++ai)
#pragma unroll
        for (int m = 0; m < 4; ++m) { const int row = row0 + ai * 128 + m * 16; const float rs = rsx[row];
          f32x4 v0 = acc[ai][0][m][0] * rs, v1 = acc[ai][0][m][1] * rs;
          rope8(v0, v1, tab + (size_t)row * 32, 16 * wc + 4 * fq);
          const u32x4 w = pack8(v0, v1);
          const int tile = row >> 6, r = row & 63, c = 16 + 4 * wc + fq;
#pragma unroll
          for (int h = 0; h < NH; ++h) *(u32x4*)((char*)kf + ((size_t)(h * 128 + tile)) * 24576 + k_img(r, c)) = w; }
    }
  }
};
struct Epi2a {
  static constexpr bool PERM = true, MIDK = false, BEGIN = false;
  bf16_t* q; const float* ssq_q; const f32x2* tab;
  __device__ __forceinline__ void mid(Acc&, int, FK_LAS unsigned char*, int, int) const {}
  __device__ __forceinline__ void operator()(const Acc& acc, const pg8::Unit& u, int wr, int wc, int fr, int fq) const {
    const int row0 = u.pm * 256 + wr * 64 + fr;
#pragma unroll
    for (int ai = 0; ai < 2; ++ai)
#pragma unroll
      for (int m = 0; m < 4; ++m) { const int row = row0 + ai * 128 + m * 16; const float rs = rsqrtf(ssq_q[row] * (1.f / 1024.f) + EPS) * QSCALE;
#pragma unroll
        for (int bj = 0; bj < 2; ++bj) { const int col = u.pn * 256 + bj * 128 + wc * 32 + 8 * fq; const int g64 = col >> 6, h = g64 / 3, part = g64 - 3 * h;
          f32x4 v0 = acc[ai][bj][m][0] * rs, v1 = acc[ai][bj][m][1] * rs;
          if (part == 2) rope8(v0, v1, tab + (size_t)row * 32, (col & 63) >> 1);
          *(u32x4*)(q + ((size_t)h * S + row) * 192 + part * 64 + (col & 63)) = pack8(v0, v1); } }
  }
};
struct Epi2b {
  static constexpr bool PERM = true, MIDK = false, BEGIN = false;
  bf16_t* kf; bf16_t* vf; const float* ssq_kv;
  __device__ __forceinline__ void mid(Acc&, int, FK_LAS unsigned char*, int, int) const {}
  __device__ __forceinline__ void operator()(const Acc& acc, const pg8::Unit& u, int wr, int wc, int fr, int fq) const {
    const int row0 = u.pm * 256 + wr * 64 + fr; const int h = u.pn; const int e = wc * 32 + 8 * fq;
#pragma unroll
    for (int ai = 0; ai < 2; ++ai)
#pragma unroll
      for (int m = 0; m < 4; ++m) { const int row = row0 + ai * 128 + m * 16; const float rs = rsqrtf(ssq_kv[row] * (1.f / 512.f) + EPS);
        const int tile = row >> 6, r = row & 63;
        *(u32x4*)((char*)kf + ((size_t)(h * 128 + tile)) * 24576 + k_img(r, e >> 3)) = pack8(acc[ai][0][m][0] * rs, acc[ai][0][m][1] * rs);
        *(u32x4*)((char*)vf + ((size_t)(h * 128 + tile)) * 16384 + v_img(r, e)) = pack8(acc[ai][1][m][0] * rs, acc[ai][1][m][1] * rs); }
  }
};
struct EpiPle {
  static constexpr bool PERM = true, MIDK = false, BEGIN = false;
  bf16_t* o; int ldc;
  __device__ __forceinline__ void mid(Acc&, int, FK_LAS unsigned char*, int, int) const {}
  __device__ __forceinline__ void operator()(const Acc& acc, const pg8::Unit& u, int wr, int wc, int fr, int fq) const {
    const int row0 = u.pm * 256 + wr * 64 + fr, col0 = u.pn * 256 + wc * 32 + 8 * fq;
#pragma unroll
    for (int ai = 0; ai < 2; ++ai)
#pragma unroll
      for (int m = 0; m < 4; ++m) { bf16_t* rowp = o + (size_t)(row0 + ai * 128 + m * 16) * ldc + col0;
#pragma unroll
        for (int bj = 0; bj < 2; ++bj) *(u32x4*)(rowp + bj * 128) = pack8(acc[ai][bj][m][0], acc[ai][bj][m][1]); }
  }
};
constexpr int EPI4_LDS = 131072 + 4096;
struct Epi4 {
  static constexpr bool PERM = false, MIDK = true, BEGIN = true;
  const float* x; float* out; bf16_t* x1b; const float* ssq_a; const float* ssq_b; float* ssq_x1;
  __device__ __forceinline__ void begin(const pg8::Unit& u, int par, FK_LAS unsigned char* lds, int tid) const {
    if (tid < 256) { const int row = u.pm * 256 + tid; FK_LAS float* f = (FK_LAS float*)(lds + EPI4_LDS + par * 2048);
      const float ra = rsqrtf(ssq_a[row] * (1.f / 2048.f) + EPS), rb = rsqrtf(ssq_b[row] * (1.f / 2048.f) + EPS); f[tid] = ra / rb; f[256 + tid] = rb; }
  }
  __device__ __forceinline__ void mid(Acc& acc, int par, FK_LAS unsigned char* lds, int wr, int fr) const {
    const FK_LAS float* f = (const FK_LAS float*)(lds + EPI4_LDS + par * 2048) + wr * 64 + fr;
#pragma unroll
    for (int ai = 0; ai < 2; ++ai)
#pragma unroll
      for (int m = 0; m < 4; ++m) { const float s = f[ai * 128 + m * 16];
#pragma unroll
        for (int bj = 0; bj < 2; ++bj)
#pragma unroll
          for (int n = 0; n < 2; ++n) acc[ai][bj][m][n] *= s; }
  }
  __device__ __forceinline__ void epi(const Acc& acc, const pg8::Unit& u, int par, FK_LAS unsigned char* lds, int wr, int wc, int fr, int fq) const {
    const int row0 = u.pm * 256 + wr * 64 + fr, col0 = u.pn * 256 + wc * 32 + 4 * fq;
    const FK_LAS float* f = (const FK_LAS float*)(lds + EPI4_LDS + par * 2048) + 256 + wr * 64 + fr;
#pragma unroll
    for (int ai = 0; ai < 2; ++ai)
#pragma unroll
      for (int m = 0; m < 4; ++m) { const int row = row0 + ai * 128 + m * 16; const float rb = f[ai * 128 + m * 16]; float ss = 0.f;
        const size_t off = (size_t)row * DM + col0;
#pragma unroll
        for (int bj = 0; bj < 2; ++bj)
#pragma unroll
          for (int n = 0; n < 2; ++n) { const f32x4 xv = *(const f32x4*)(x + off + bj * 128 + n * 16); const f32x4 v = xv + acc[ai][bj][m][n] * rb;
            ss += (v[0] * v[0] + v[1] * v[1]) + (v[2] * v[2] + v[3] * v[3]);
            u32x2 w; w.x = cvt_pk_bf16(v[0], v[1]); w.y = cvt_pk_bf16(v[2], v[3]); *(u32x2*)(x1b + off + bj * 128 + n * 16) = w; }
        ss += __shfl_xor(ss, 16); ss += __shfl_xor(ss, 32); if (fq == 0) atomicAdd(ssq_x1 + row, ss);
        if (FK_EPI_FENCE == 1 || (FK_EPI_FENCE == 2 && (m & 1)) || (FK_EPI_FENCE == 4 && m == 3)) asm volatile("" ::: "memory"); }
  }
  __device__ __forceinline__ void operator()(const Acc&, const pg8::Unit&, int, int, int, int) const {}
};
struct Epi5 {
  static constexpr bool PERM = false, MIDK = false, BEGIN = false;
  const bf16_t* x1b; bf16_t* x2b; const bf16_t* ple; const float* ssq_x1; float* ssq_x2;
  __device__ __forceinline__ void mid(Acc&, int, FK_LAS unsigned char*, int, int) const {}
  __device__ __forceinline__ void operator()(const Acc& acc, const pg8::Unit& u, int wr, int wc, int fr, int fq) const {
    const int row0 = u.pm * 256 + wr * 64 + fr, col0 = u.pn * 256 + wc * 32 + 4 * fq;
#pragma unroll
    for (int ai = 0; ai < 2; ++ai)
#pragma unroll
      for (int m = 0; m < 4; ++m) { const int row = row0 + ai * 128 + m * 16; const float r1 = rsqrtf(ssq_x1[row] * (1.f / 4096.f) + EPS) * -LOG2E; float ss = 0.f;
        const size_t off = (size_t)row * DM + col0;
#pragma unroll
        for (int bj = 0; bj < 2; ++bj)
#pragma unroll
          for (int n = 0; n < 2; ++n) { const u32x2 xw = *(const u32x2*)(x1b + off + bj * 128 + n * 16); const u32x2 pw = *(const u32x2*)(ple + off + bj * 128 + n * 16);
            const f32x4 z = acc[ai][bj][m][n] * r1; f32x4 v;
            v[0] = bflo(xw.x) + bflo(pw.x) * __builtin_amdgcn_rcpf(1.f + __builtin_amdgcn_exp2f(z[0])); v[1] = bfhi(xw.x) + bfhi(pw.x) * __builtin_amdgcn_rcpf(1.f + __builtin_amdgcn_exp2f(z[1]));
            v[2] = bflo(xw.y) + bflo(pw.y) * __builtin_amdgcn_rcpf(1.f + __builtin_amdgcn_exp2f(z[2])); v[3] = bfhi(xw.y) + bfhi(pw.y) * __builtin_amdgcn_rcpf(1.f + __builtin_amdgcn_exp2f(z[3]));
            ss += (v[0] * v[0] + v[1] * v[1]) + (v[2] * v[2] + v[3] * v[3]);
            u32x2 w; w.x = cvt_pk_bf16(v[0], v[1]); w.y = cvt_pk_bf16(v[2], v[3]); *(u32x2*)(x2b + off + bj * 128 + n * 16) = w; }
        ss += __shfl_xor(ss, 16); ss += __shfl_xor(ss, 32); if (fq == 0) atomicAdd(ssq_x2 + row, ss);
        if (FK_EPI_FENCE == 1 || (FK_EPI_FENCE == 2 && (m & 1)) || (FK_EPI_FENCE == 4 && m == 3)) asm volatile("" ::: "memory"); }
  }
};

__device__ __forceinline__ void transpose_item(const float* Wm, int N, const float* gain, bf16_t* WT, int K, int k0, int n0, int drow0, int dstep, FK_LAS float* scr, int lane) {
  const int nq = lane & 7, kr = lane >> 3;
  f32x4 v[8]; float gk[8];
#pragma unroll
  for (int i = 0; i < 8; ++i) v[i] = *(const f32x4*)(Wm + (size_t)(k0 + kr + 8 * i) * N + n0 + 4 * nq);
#pragma unroll
  for (int i = 0; i < 8; ++i) gk[i] = gain ? gain[k0 + kr + 8 * i] : 1.f;
#pragma unroll
  for (int i = 0; i < 8; ++i) { FK_LAS float* d = scr + (kr + 8 * i) * 33 + 4 * nq; const f32x4 t = v[i] * gk[i]; d[0] = t[0]; d[1] = t[1]; d[2] = t[2]; d[3] = t[3]; }
  asm volatile("s_waitcnt lgkmcnt(0)" ::: "memory");
  const int c = lane & 7;
#pragma unroll
  for (int j = 0; j < 4; ++j) { const int n = (lane >> 3) + 8 * j; const FK_LAS float* s = scr + (8 * c) * 33 + n;
    u32x4 o; o.x = cvt_pk_bf16(s[0 * 33], s[1 * 33]); o.y = cvt_pk_bf16(s[2 * 33], s[3 * 33]); o.z = cvt_pk_bf16(s[4 * 33], s[5 * 33]); o.w = cvt_pk_bf16(s[6 * 33], s[7 * 33]);
    *(u32x4*)(WT + (size_t)(drow0 + n * dstep) * K + k0 + 8 * c) = o; }
  asm volatile("s_waitcnt lgkmcnt(0)" ::: "memory");
}
__device__ __forceinline__ void prologue(const Ptrs& P, const W& w, FK_LAS unsigned char* lds, int vcu, int G) {
  const int tid = threadIdx.x, lane = tid & 63, wave = tid >> 6;
  FK_LAS float* scr = (FK_LAS float*)(lds + wave * 16384);
  const int gw = vcu * 8 + wave, NGW = G * 8;
  const int gt = vcu * 512 + tid, NGT = G * 512;
  constexpr int I_IN = 64 * (INW / 32), I_UQ = 16 * 96, I_UKV = 8 * 128, I_OUT = 64 * 128, I_PLE = 4 * 128, I_PG = 64 * 128;
  constexpr int NIT = I_IN + I_UQ + I_UKV + I_OUT + I_PLE + I_PG;
  for (int it = gw; it < NIT; it += NGW) {
    int r = it;
    if (r < I_IN) { const int nb = r % (INW / 32), kb = r / (INW / 32), n0 = nb * 32; int d0, st = 1;
      if (n0 < 1536) d0 = n0; else if (n0 == 1536) { d0 = PW; st = 2; } else if (n0 == 1568) { d0 = PW + 1; st = 2; } else d0 = n0 - 64;
      transpose_item(P.w_in, INW, P.g_mix, w.win, 4096, kb * 64, n0, d0, st, scr, lane); continue; } r -= I_IN;
    if (r < I_UQ) { const int nb = r % 96, kb = r / 96, n0 = nb * 32, h = n0 / 192, d = n0 - h * 192; int d0 = n0, st = 1;
      if (d == 128) { d0 = h * 192 + 128; st = 2; } else if (d == 160) { d0 = h * 192 + 129; st = 2; }
      transpose_item(P.w_uq, 3072, P.g_q, w.wuq, 1024, kb * 64, n0, d0, st, scr, lane); continue; } r -= I_UQ;
    if (r < I_UKV) { const int nb = r % 128, kb = r / 128; transpose_item(P.w_ukv, 4096, P.g_kv, w.wukv, 512, kb * 64, nb * 32, nb * 32, 1, scr, lane); continue; } r -= I_UKV;
    if (r < I_OUT) { const int nb = r % 128, kb = r / 128; transpose_item(P.w_out, 4096, kb < 32 ? P.g_oa : P.g_ob - 2048, w.wout, 4096, kb * 64, nb * 32, nb * 32, 1, scr, lane); continue; } r -= I_OUT;
    if (r < I_PLE) { const int nb = r % 128, kb = r / 128; transpose_item(P.w_ple, 4096, nullptr, w.wple, 256, kb * 64, nb * 32, nb * 32, 1, scr, lane); continue; } r -= I_PLE;
    { const int nb = r % 128, kb = r / 128; transpose_item(P.w_pg, 4096, P.g_ple, w.wpg, 4096, kb * 64, nb * 32, nb * 32, 1, scr, lane); }
  }
  for (int row = gw; row < S; row += NGW) {
    const f32x4* xr = (const f32x4*)(P.x + (size_t)row * DM) + lane; u32x2* o8 = (u32x2*)(w.xb + (size_t)row * DM) + lane; float s = 0.f;
#pragma unroll
    for (int j = 0; j < 16; ++j) { const f32x4 v = xr[64 * j]; s += (v[0] * v[0] + v[1] * v[1]) + (v[2] * v[2] + v[3] * v[3]); u32x2 o; o.x = cvt_pk_bf16(v[0], v[1]); o.y = cvt_pk_bf16(v[2], v[3]); o8[64 * j] = o; }
    s = wave_sum(s);
    if (lane == 0) w.rs_x[row] = rsqrtf(s * (1.f / 4096.f) + EPS);
  }
  for (int i = gt; i < S * 256 / 8; i += NGT) { const f32x4 a = ((const f32x4*)P.p)[2 * i], b = ((const f32x4*)P.p)[2 * i + 1]; ((u32x4*)w.pb)[i] = pack8(a, b); }
  for (int i = gt; i < S * 32; i += NGT) { const int s = i >> 5, j = i & 31; const float inv = powf(10000.f, -(float)j / 32.f); const float ang = (float)P.pos[s] * inv; f32x2 cs; cs.x = cosf(ang); cs.y = sinf(ang); w.tab[i] = cs; }
  for (int i = gt; i < 6 * S; i += NGT) w.ssq_q[i] = 0.f;
  for (int i = gt; i < (N1 - INW) * 4096 / 8; i += NGT) ((u32x4*)(w.win + (size_t)INW * 4096))[i] = (u32x4){0u, 0u, 0u, 0u};
}

constexpr int STG_ROW = 272, STG_BYTES = 32 * STG_ROW;
__device__ __forceinline__ void stage_tile(FK_LAS unsigned char* st, const f32x16 (&o)[4], const FK_LAS float* lsum, int r32, int hi) {
#pragma unroll
  for (int r = 0; r < 16; ++r) { const float rl = __builtin_amdgcn_rcpf(lsum[crow(r, hi)]); FK_LAS unsigned short* rowp = (FK_LAS unsigned short*)(st + crow(r, hi) * STG_ROW) + r32;
#pragma unroll
    for (int d0 = 0; d0 < 4; ++d0) rowp[d0 * 32] = (unsigned short)(cvt_pk_bf16(o[d0][r] * rl, 0.f) & 0xffffu); }
  asm volatile("s_waitcnt lgkmcnt(0)" ::: "memory");
}
namespace mla {
constexpr int KB = 24576, VB = 16384, K_OFF = 0, V_OFF = 3 * KB, SCR_OFF = 3 * KB + 3 * VB, LDS_BYTES = SCR_OFF + 8 * 256;
constexpr float THR2 = 11.5f;
__device__ __forceinline__ void partialSM(f32x16& p0, f32x16& p1, float& m_reg, float& alpha) {
  float pmax = p0[0];
#pragma unroll
  for (int r = 1; r < 16; ++r) pmax = fmaxf(pmax, p0[r]);
#pragma unroll
  for (int r = 0; r < 16; ++r) pmax = fmaxf(pmax, p1[r]);
  { auto rr = __builtin_amdgcn_permlane32_swap(__float_as_uint(pmax), __float_as_uint(pmax), false, false); pmax = fmaxf(__uint_as_float(rr[0]), __uint_as_float(rr[1])); }
  float mn;
  if (__builtin_expect(__all(pmax - m_reg <= THR2), 1)) { mn = m_reg; alpha = 1.f; }
  else { mn = fmaxf(m_reg, pmax); alpha = __builtin_amdgcn_exp2f(m_reg - mn); m_reg = mn; }
#pragma unroll
  for (int r = 0; r < 16; ++r) p0[r] = p0[r] - mn;
#pragma unroll
  for (int r = 0; r < 16; ++r) p1[r] = p1[r] - mn;
#pragma unroll
  for (int r = 0; r < 16; ++r) p0[r] = __builtin_amdgcn_exp2f(p0[r]);
}
#define FK_PK4(P, BASE, OUT) do { unsigned a0 = cvt_pk_bf16(P[BASE + 0], P[BASE + 1]), a1 = cvt_pk_bf16(P[BASE + 2], P[BASE + 3]); \
    unsigned b0 = cvt_pk_bf16(P[BASE + 4], P[BASE + 5]), b1 = cvt_pk_bf16(P[BASE + 6], P[BASE + 7]); \
    auto r0 = __builtin_amdgcn_permlane32_swap(a0, b0, false, false); auto r1 = __builtin_amdgcn_permlane32_swap(a1, b1, false, false); \
    u32x4 w_ = {r0[0], r1[0], r0[1], r1[1]}; OUT = *reinterpret_cast<bf16x8*>(&w_); } while (0)
__device__ __forceinline__ void finishSM_a(f32x16& p0, f32x16& p1, float alpha, float& l_reg) {
#pragma unroll
  for (int r = 0; r < 16; ++r) p1[r] = __builtin_amdgcn_exp2f(p1[r]);
  float ps = 0.f;
#pragma unroll
  for (int r = 0; r < 16; ++r) ps += p0[r];
#pragma unroll
  for (int r = 0; r < 16; ++r) ps += p1[r];
  { auto rr = __builtin_amdgcn_permlane32_swap(__float_as_uint(ps), __float_as_uint(ps), false, false); ps = __uint_as_float(rr[0]) + __uint_as_float(rr[1]); }
  l_reg = l_reg * alpha + ps;
}
__device__ __forceinline__ void finishSM_b(const f32x16& p0, const f32x16& p1, bf16x8& pa0, bf16x8& pa1, bf16x8& pa2, bf16x8& pa3) {
  FK_PK4(p0, 0, pa0); FK_PK4(p0, 8, pa1); FK_PK4(p1, 0, pa2); FK_PK4(p1, 8, pa3);
}
#define FK_PKV(L, H) (bf16x8){L[0], L[1], L[2], L[3], H[0], H[1], H[2], H[3]}
#define FK_KRD(A_, B_, D0_) asm volatile("ds_read_b128 %0, %2 offset:%3\n\tds_read_b128 %1, %2 offset:%4" : "=&v"(A_), "=&v"(B_) : "v"(ka[(D0_) & 3]), "i"(128 * ((D0_) >> 2)), "i"(128 * ((D0_) >> 2) + 12288) : "memory")
#define FK_KWAIT(N_, A_, B_) asm volatile("s_waitcnt lgkmcnt(" #N_ ")" : "+v"(A_), "+v"(B_) :: "memory")
#ifndef FK_KDEPTH
#define FK_KDEPTH 2
#endif
#ifndef FK_PRIO
#define FK_PRIO 0
#endif
#define FK_KSTEP(P0, P1, D0_, N_, A_, B_) do { FK_KWAIT(N_, A_, B_); if (FK_PRIO) __builtin_amdgcn_s_setprio(1); P0 = __builtin_amdgcn_mfma_f32_32x32x16_bf16(A_, qr[D0_], P0, 0, 0, 0); P1 = __builtin_amdgcn_mfma_f32_32x32x16_bf16(B_, qr[D0_], P1, 0, 0, 0); if (FK_PRIO) __builtin_amdgcn_s_setprio(0); \
    if ((D0_) + FK_KDEPTH < 12) FK_KRD(A_, B_, (D0_) + FK_KDEPTH < 12 ? (D0_) + FK_KDEPTH : 0); } while (0)
#if FK_KDEPTH == 3
#define FK_QKT(P0, P1, KBASE) do { int ka[4]; _Pragma("unroll") for (int q_ = 0; q_ < 4; ++q_) ka[q_] = kb[q_] + (KBASE); \
    bf16x8 xa, xb, ya, yb, za, zb; P0 = (f32x16){}; P1 = (f32x16){}; FK_KRD(xa, xb, 0); FK_KRD(ya, yb, 1); FK_KRD(za, zb, 2); \
    FK_KSTEP(P0, P1, 0, 4, xa, xb); FK_KSTEP(P0, P1, 1, 4, ya, yb); FK_KSTEP(P0, P1, 2, 4, za, zb); FK_KSTEP(P0, P1, 3, 4, xa, xb); FK_KSTEP(P0, P1, 4, 4, ya, yb); FK_KSTEP(P0, P1, 5, 4, za, zb); \
    FK_KSTEP(P0, P1, 6, 4, xa, xb); FK_KSTEP(P0, P1, 7, 4, ya, yb); FK_KSTEP(P0, P1, 8, 4, za, zb); FK_KSTEP(P0, P1, 9, 4, xa, xb); FK_KSTEP(P0, P1, 10, 2, ya, yb); FK_KSTEP(P0, P1, 11, 0, za, zb); } while (0)
#else
#define FK_QKT(P0, P1, KBASE) do { int ka[4]; _Pragma("unroll") for (int q_ = 0; q_ < 4; ++q_) ka[q_] = kb[q_] + (KBASE); \
    bf16x8 xa, xb, ya, yb; P0 = (f32x16){}; P1 = (f32x16){}; FK_KRD(xa, xb, 0); FK_KRD(ya, yb, 1); \
    FK_KSTEP(P0, P1, 0, 2, xa, xb); FK_KSTEP(P0, P1, 1, 2, ya, yb); FK_KSTEP(P0, P1, 2, 2, xa, xb); FK_KSTEP(P0, P1, 3, 2, ya, yb); FK_KSTEP(P0, P1, 4, 2, xa, xb); FK_KSTEP(P0, P1, 5, 2, ya, yb); \
    FK_KSTEP(P0, P1, 6, 2, xa, xb); FK_KSTEP(P0, P1, 7, 2, ya, yb); FK_KSTEP(P0, P1, 8, 2, xa, xb); FK_KSTEP(P0, P1, 9, 2, ya, yb); FK_KSTEP(P0, P1, 10, 2, xa, xb); FK_KSTEP(P0, P1, 11, 0, ya, yb); } while (0)
#endif
#define FK_TRD8(L0, H0, L1, H1, L2, H2, L3, H3, D0_) do { L0 = tr_read<v_rd_off(D0_, 0, 0)>(vb_); H0 = tr_read<v_rd_off(D0_, 0, 1)>(vb_); L1 = tr_read<v_rd_off(D0_, 1, 0)>(vb_); H1 = tr_read<v_rd_off(D0_, 1, 1)>(vb_); \
    L2 = tr_read<v_rd_off(D0_, 2, 0)>(vb_); H2 = tr_read<v_rd_off(D0_, 2, 1)>(vb_); L3 = tr_read<v_rd_off(D0_, 3, 0)>(vb_); H3 = tr_read<v_rd_off(D0_, 3, 1)>(vb_); } while (0)
#define FK_VWAIT(N_, L0, H0, L1, H1, L2, H2, L3, H3) asm volatile("s_waitcnt lgkmcnt(" #N_ ")" : "+v"(L0), "+v"(H0), "+v"(L1), "+v"(H1), "+v"(L2), "+v"(H2), "+v"(L3), "+v"(H3) :: "memory")
#define FK_PV4(OD, L0, H0, L1, H1, L2, H2, L3, H3) do { if (FK_PRIO) __builtin_amdgcn_s_setprio(1); OD = __builtin_amdgcn_mfma_f32_32x32x16_bf16(pa0, FK_PKV(L0, H0), OD, 0, 0, 0); OD = __builtin_amdgcn_mfma_f32_32x32x16_bf16(pa1, FK_PKV(L1, H1), OD, 0, 0, 0); \
    OD = __builtin_amdgcn_mfma_f32_32x32x16_bf16(pa2, FK_PKV(L2, H2), OD, 0, 0, 0); OD = __builtin_amdgcn_mfma_f32_32x32x16_bf16(pa3, FK_PKV(L3, H3), OD, 0, 0, 0); if (FK_PRIO) __builtin_amdgcn_s_setprio(0); } while (0)
#define FK_PV_DECL s16x4 al0, ah0, al1, ah1, al2, ah2, al3, ah3, bl0, bh0, bl1, bh1, bl2, bh2, bl3, bh3
#define FK_PV_ISSUE(VBASE) const int vb_ = vb0 + (VBASE); FK_TRD8(al0, ah0, al1, ah1, al2, ah2, al3, ah3, 0); FK_TRD8(bl0, bh0, bl1, bh1, bl2, bh2, bl3, bh3, 1)
#define FK_PV_REST() do { \
    FK_VWAIT(8, al0, ah0, al1, ah1, al2, ah2, al3, ah3); FK_PV4(o[0], al0, ah0, al1, ah1, al2, ah2, al3, ah3); FK_TRD8(al0, ah0, al1, ah1, al2, ah2, al3, ah3, 2); \
    FK_VWAIT(8, bl0, bh0, bl1, bh1, bl2, bh2, bl3, bh3); FK_PV4(o[1], bl0, bh0, bl1, bh1, bl2, bh2, bl3, bh3); FK_TRD8(bl0, bh0, bl1, bh1, bl2, bh2, bl3, bh3, 3); \
    FK_VWAIT(8, al0, ah0, al1, ah1, al2, ah2, al3, ah3); FK_PV4(o[2], al0, ah0, al1, ah1, al2, ah2, al3, ah3); \
    FK_VWAIT(0, bl0, bh0, bl1, bh1, bl2, bh2, bl3, bh3); FK_PV4(o[3], bl0, bh0, bl1, bh1, bl2, bh2, bl3, bh3); } while (0)
__device__ __forceinline__ void epilogue(FK_LAS unsigned char* lds, const W& w, int h, int q0, const f32x16 (&o)[4], float l_reg) {
  const int lane = (int)__builtin_amdgcn_mbcnt_hi(~0u, __builtin_amdgcn_mbcnt_lo(~0u, 0u)); const int r32 = lane & 31, hi = lane >> 5;
  const int wid = __builtin_amdgcn_readfirstlane((int)threadIdx.x >> 6);
  FK_LAS float* al_l = (FK_LAS float*)(lds + SCR_OFF + wid * 256);
  if (hi == 0) al_l[r32] = l_reg; asm volatile("s_waitcnt lgkmcnt(0)" ::: "memory");
  const int rowb = q0 + wid * 32;
#pragma unroll
  for (int r = 0; r < 16; ++r) { const float rl = __builtin_amdgcn_rcpf(al_l[crow(r, hi)]); float ss = 0.f;
#pragma unroll
    for (int d0 = 0; d0 < 4; ++d0) { const float v = o[d0][r] * rl; ss += v * v; }
    ss += __shfl_xor(ss, 1); ss += __shfl_xor(ss, 2); ss += __shfl_xor(ss, 4); ss += __shfl_xor(ss, 8); ss += __shfl_xor(ss, 16);
    if (r32 == 0) atomicAdd(w.ssq_a + rowb + crow(r, hi), ss); }
  FK_LAS unsigned char* st = lds + K_OFF + wid * STG_BYTES;
  stage_tile(st, o, al_l, r32, hi);
#pragma unroll
  for (int i = 0; i < 8; ++i) { const int q = lane + 64 * i, row = q >> 4, ch = q & 15; const int orow = rowb + row;
    const u32x4 v = *(const FK_LAS u32x4*)(st + row * STG_ROW + ch * 16); const u32x4 g = *(const u32x4*)(w.proj + (size_t)orow * PW + PC_GA + h * 128 + ch * 8);
    u32x4 y;
#pragma unroll
    for (int e = 0; e < 4; ++e) y[e] = cvt_pk_bf16(bflo(v[e]) * silu(bflo(g[e])), bfhi(v[e]) * silu(bfhi(g[e])));
    *(u32x4*)(w.y + (size_t)orow * DM + h * 128 + ch * 8) = y; }
}
__device__ __forceinline__ void unit2(FK_LAS unsigned char* lds, const W& w, int h, int q0, int) {
  int tid = threadIdx.x; asm volatile("" : "+v"(tid));
  const int wid = __builtin_amdgcn_readfirstlane(tid >> 6), lane = tid & 63, r32 = lane & 31, hi = lane >> 5;
  FK_LAS float* al_l = (FK_LAS float*)(lds + SCR_OFF + wid * 256);
  const char* Kg = (const char*)w.kf + (size_t)h * 128 * KB + wid * 3072; const char* Vg = (const char*)w.vf + (size_t)h * 128 * VB + wid * 2048;
  const unsigned lane16 = (unsigned)lane * 16u;
  constexpr int NT = S / 64;
#define FK_DMA_K(j, sl) do { const char* g_ = Kg + (size_t)(j) * KB + lane16; FK_LAS unsigned char* d_ = lds + K_OFF + (sl) * KB + wid * 3072; \
    _Pragma("unroll") for (int i_ = 0; i_ < 3; ++i_) __builtin_amdgcn_global_load_lds((const unsigned*)(g_ + i_ * 1024), (FK_LAS unsigned*)(d_ + i_ * 1024), 16, 0, 0); } while (0)
#define FK_DMA_V(j, sl) do { const char* g_ = Vg + (size_t)(j) * VB + lane16; FK_LAS unsigned char* d_ = lds + V_OFF + (sl) * VB + wid * 2048; \
    _Pragma("unroll") for (int i_ = 0; i_ < 2; ++i_) __builtin_amdgcn_global_load_lds((const unsigned*)(g_ + i_ * 1024), (FK_LAS unsigned*)(d_ + i_ * 1024), 16, 0, 0); } while (0)
#define FK_RESC(a) do { if (__any((a) < 1.f)) { if (hi == 0) al_l[r32] = (a); asm volatile("s_waitcnt lgkmcnt(0)" ::: "memory"); \
    _Pragma("unroll") for (int r_ = 0; r_ < 16; ++r_) { const float f_ = al_l[crow(r_, hi)]; _Pragma("unroll") for (int d_ = 0; d_ < 4; ++d_) o[d_][r_] *= f_; } } } while (0)
  FK_DMA_K(0, 0); FK_DMA_V(0, 0); FK_DMA_K(1, 1);
  bf16x8 qr[12];
  { const bf16_t* Qw = w.q + ((size_t)h * S + q0 + wid * 32 + r32) * 192 + hi * 8;
#pragma unroll
    for (int d0 = 0; d0 < 12; ++d0) qr[d0] = *(const bf16x8*)(Qw + d0 * 16); }
  float m_reg = -1e30f, l_reg = 0.f; f32x16 o[4];
#pragma unroll
  for (int d = 0; d < 4; ++d) o[d] = (f32x16){};
  f32x16 pA0, pA1, pB0, pB1; float alA, alB; bf16x8 pa0, pa1, pa2, pa3;
  const int vb0 = (int)(unsigned)(size_t)(lds + V_OFF) + v_rd_base(lane);
  int kb[4];
#pragma unroll
  for (int q_ = 0; q_ < 4; ++q_) kb[q_] = (int)(unsigned)(size_t)(lds + K_OFF) + r32 * 384 + (((2 * q_ + hi) ^ ((r32 >> 1) & 7)) << 4);
  asm volatile("s_waitcnt vmcnt(3)" ::: "memory"); __builtin_amdgcn_s_barrier();
  FK_DMA_K(2, 2); FK_DMA_V(1, 1);
  FK_QKT(pA0, pA1, 0); partialSM(pA0, pA1, m_reg, alA);
  int sk = 1, sv = 0;
  for (int j = 1; j < NT; j += 2) {
    asm volatile("s_waitcnt vmcnt(5)" ::: "memory"); __builtin_amdgcn_s_barrier();
    { const int fv = sv == 0 ? 2 : sv - 1; FK_DMA_K(j + 2 < NT ? j + 2 : NT - 1, sv); FK_DMA_V(j + 1 < NT ? j + 1 : NT - 1, fv); }
    FK_QKT(pB0, pB1, sk * KB);
    finishSM_a(pA0, pA1, alA, l_reg); __builtin_amdgcn_sched_barrier(0);
    { FK_PV_DECL; FK_PV_ISSUE(sv * VB); finishSM_b(pA0, pA1, pa0, pa1, pa2, pa3); FK_PV_REST(); } partialSM(pB0, pB1, m_reg, alB);
    FK_RESC(alB);
    sv = sk; sk = sk == 2 ? 0 : sk + 1;
    asm volatile("s_waitcnt vmcnt(5)" ::: "memory"); __builtin_amdgcn_s_barrier();
    if (j + 1 < NT) {
      { const int fv = sv == 0 ? 2 : sv - 1; FK_DMA_K(j + 3 < NT ? j + 3 : NT - 1, sv); FK_DMA_V(j + 2 < NT ? j + 2 : NT - 1, fv); }
      FK_QKT(pA0, pA1, sk * KB);
    }
    finishSM_a(pB0, pB1, alB, l_reg); __builtin_amdgcn_sched_barrier(0);
    { FK_PV_DECL; FK_PV_ISSUE(sv * VB); finishSM_b(pB0, pB1, pa0, pa1, pa2, pa3); FK_PV_REST(); }
    if (j + 1 < NT) { partialSM(pA0, pA1, m_reg, alA); FK_RESC(alA); }
    sv = sk; sk = sk == 2 ? 0 : sk + 1;
  }
  asm volatile("s_waitcnt vmcnt(0)" ::: "memory"); __builtin_amdgcn_s_barrier();
  epilogue(lds, w, h, q0, o, l_reg);
  __builtin_amdgcn_s_barrier();
#undef FK_DMA_K
#undef FK_DMA_V
#undef FK_RESC
}
__device__ __forceinline__ void epilogue_unused_marker() {}
#if 0
  const int rowb = q0 + wid * 32;
#pragma unroll
  for (int r = 0; r < 16; ++r) { const int orow = rowb + crow(r, hi); const float rl = __builtin_amdgcn_rcpf(al_l[crow(r, hi)]); float ss = 0.f;
    const bf16_t* gp = w.proj + (size_t)orow * PW + PC_GA + h * 128 + r32; bf16_t* yp = w.y + (size_t)orow * DM + h * 128 + r32;
    float g4[4];
#pragma unroll
    for (int d0 = 0; d0 < 4; ++d0) g4[d0] = bf2f(gp[d0 * 32]);
#pragma unroll
    for (int d0 = 0; d0 < 4; ++d0) { const float v = o[d0][r] * rl; ss += v * v; yp[d0 * 32] = (bf16_t)(cvt_pk_bf16(v * silu(g4[d0]), 0.f) & 0xffffu); }
    ss += __shfl_xor(ss, 1); ss += __shfl_xor(ss, 2); ss += __shfl_xor(ss, 4); ss += __shfl_xor(ss, 8); ss += __shfl_xor(ss, 16);
    if (r32 == 0) atomicAdd(w.ssq_a + orow, ss); }
#endif

}

namespace dil {
constexpr int WAVE_LDS = 16384;
constexpr size_t WS_DO0 = 4 * MiB, WS_DO1 = 36 * MiB, WS_DO2 = 174 * MiB, WS_LSE = 206 * MiB;
__device__ __forceinline__ int kswz(int row, int chunk) { return row * 256 + ((chunk ^ (row & 15)) << 4); }
__device__ __forceinline__ bf16_t* dopart(unsigned char* ws, int pat) { return (bf16_t*)(ws + (pat == 0 ? WS_DO0 : (pat == 1 ? WS_DO1 : WS_DO2))); }
constexpr int RING = 9;
__device__ __forceinline__ void wg_item(FK_LAS unsigned char* lds, const W& w, unsigned char* ws, int pat, int h, int c, int qbg, int wave, int lane, int skip, bool fin) {
  const int r32 = lane & 31, hi = lane >> 5;
  FK_LAS float* al_l = (FK_LAS float*)(lds + RING * WAVE_LDS + wave * 256);
  const int d = pat == 0 ? 1 : (pat == 1 ? 4 : 16); const int L = S / d; const int J0 = 256 * qbg, j0 = J0 + 32 * wave;
  const float nad = -exp2f(-8.f * (float)(h + 1) / 16.f) * LOG2E * (float)d;
  const int kr = lane >> 4, kc = lane & 15;
  const size_t rstep = (size_t)4 * d * PW;
  const bf16_t* kvbase = w.proj + (size_t)c * PW + h * 128 + kc * 8;
  { const int p0 = J0 - 64 + 32 * wave;
    if (p0 >= 0 && p0 < L && !(skip & 8)) { u32x4 kreg[8], vreg[8]; const bf16_t* base = kvbase + (size_t)(d * (p0 + kr)) * PW; FK_LAS unsigned char* wl = lds + wave * WAVE_LDS;
#pragma unroll
      for (int i = 0; i < 8; ++i) { kreg[i] = *(const u32x4*)(base + i * rstep + PC_KB); vreg[i] = *(const u32x4*)(base + i * rstep + PC_VB); }
#pragma unroll
      for (int i = 0; i < 8; ++i) { const int row = kr + 4 * i; *(FK_LAS u32x4*)(wl + kswz(row, kc)) = kreg[i]; *(FK_LAS u32x4*)(wl + 8192 + v_img(row, kc * 8)) = vreg[i]; } } }
  bf16x8 qr[8];
  { const bf16_t* Qw = w.proj + (size_t)(c + d * (j0 + r32)) * PW + PC_QB + h * 128 + hi * 8;
#pragma unroll
    for (int d0 = 0; d0 < 8; ++d0) qr[d0] = *(const bf16x8*)(Qw + d0 * 16); }
  float m_reg = 0.f, l_reg = 0.f; f32x16 o[4]; bool started = false;
#pragma unroll
  for (int dd = 0; dd < 4; ++dd) o[dd] = (f32x16){};
#define FK_COOP(t_, KN, VN, OK) do { const int pn_ = J0 - 64 + 32 * (t_); OK = ((t_) < 12) && (pn_ < L) && !(skip & 8); \
    if (OK) { const bf16_t* b_ = kvbase + (size_t)(d * (pn_ + 4 * wave + kr)) * PW; KN = *(const u32x4*)(b_ + PC_KB); VN = *(const u32x4*)(b_ + PC_VB); } } while (0)
  u32x4 kn, vn, kn2, vn2; bool ld, ld2;
  FK_COOP(8, kn, vn, ld);
  __syncthreads();
#pragma unroll 1
  for (int sb = 0; sb < 5; ++sb) {
    FK_COOP(9 + sb, kn2, vn2, ld2);
    const int t = wave + sb; const int p0 = J0 - 64 + 32 * t;
    if (p0 >= 0 && p0 < L && !(skip & 4)) {
      FK_LAS unsigned char* wl = lds + (t % RING) * WAVE_LDS; const int vb0 = (int)(unsigned)(size_t)(wl + 8192) + v_rd_base(lane);
      f32x16 p = (f32x16){};
#pragma unroll
      for (int d0 = 0; d0 < 8; ++d0) { const bf16x8 kf = *(const FK_LAS bf16x8*)(wl + kswz(r32, 2 * d0 + hi)); p = __builtin_amdgcn_mfma_f32_32x32x16_bf16(kf, qr[d0], p, 0, 0, 0); }
      const float basef = (float)(32 * sb - 64 + 4 * hi - r32);
      if (sb == 0 || sb == 4) {
#pragma unroll
        for (int r = 0; r < 16; ++r) { const float tt = basef + (float)((r & 3) + 8 * (r >> 2)); p[r] = (__builtin_fabsf(tt) <= 64.f) ? fmaf(nad, __builtin_fabsf(tt), p[r]) : -INFINITY; }
      } else {
#pragma unroll
        for (int r = 0; r < 16; ++r) { const float tt = basef + (float)((r & 3) + 8 * (r >> 2)); p[r] = fmaf(nad, __builtin_fabsf(tt), p[r]); }
      }
      float pmax = p[0];
#pragma unroll
      for (int r = 1; r < 16; ++r) pmax = fmaxf(pmax, p[r]);
      { auto rr = __builtin_amdgcn_permlane32_swap(__float_as_uint(pmax), __float_as_uint(pmax), false, false); pmax = fmaxf(__uint_as_float(rr[0]), __uint_as_float(rr[1])); }
      if (!started) { m_reg = pmax; started = true; }
      else if (!__all(pmax - m_reg <= mla::THR2)) {
        const float mn = fmaxf(m_reg, pmax); const float alpha = __builtin_amdgcn_exp2f(m_reg - mn); m_reg = mn; l_reg *= alpha;
        if (hi == 0) al_l[r32] = alpha; asm volatile("s_waitcnt lgkmcnt(0)" ::: "memory");
#pragma unroll
        for (int r = 0; r < 16; ++r) { const float f = al_l[crow(r, hi)];
#pragma unroll
          for (int dd = 0; dd < 4; ++dd) o[dd][r] *= f; } }
      float ps = 0.f;
#pragma unroll
      for (int r = 0; r < 16; ++r) { p[r] = __builtin_amdgcn_exp2f(p[r] - m_reg); ps += p[r]; }
      { auto rr = __builtin_amdgcn_permlane32_swap(__float_as_uint(ps), __float_as_uint(ps), false, false); ps = __uint_as_float(rr[0]) + __uint_as_float(rr[1]); }
      l_reg += ps;
      bf16x8 pa0, pa1; FK_PK4(p, 0, pa0); FK_PK4(p, 8, pa1);
#define FK_DPV(D0) do { const s16x4 l0 = tr_read<v_rd_off(D0, 0, 0)>(vb0), h0 = tr_read<v_rd_off(D0, 0, 1)>(vb0), l1 = tr_read<v_rd_off(D0, 1, 0)>(vb0), h1 = tr_read<v_rd_off(D0, 1, 1)>(vb0); \
        asm volatile("s_waitcnt lgkmcnt(0)" ::: "memory"); __builtin_amdgcn_sched_barrier(0); \
        o[D0] = __builtin_amdgcn_mfma_f32_32x32x16_bf16(pa0, FK_PKV(l0, h0), o[D0], 0, 0, 0); o[D0] = __builtin_amdgcn_mfma_f32_32x32x16_bf16(pa1, FK_PKV(l1, h1), o[D0], 0, 0, 0); } while (0)
      if (!(skip & 2)) { FK_DPV(0); FK_DPV(1); FK_DPV(2); FK_DPV(3); }
#undef FK_DPV
    }
    if (ld) { FK_LAS unsigned char* wn = lds + ((8 + sb) % RING) * WAVE_LDS; const int row = 4 * wave + kr; *(FK_LAS u32x4*)(wn + kswz(row, kc)) = kn; *(FK_LAS u32x4*)(wn + 8192 + v_img(row, kc * 8)) = vn; }
    kn = kn2; vn = vn2; ld = ld2;
    __syncthreads();
  }
#undef FK_COOP
  if (skip & 1) return;
  if (hi == 0) al_l[r32] = l_reg; asm volatile("s_waitcnt lgkmcnt(0)" ::: "memory");
  FK_LAS unsigned char* st = lds + wave * WAVE_LDS;
  stage_tile(st, o, al_l, r32, hi);
  if (!fin) {
    bf16_t* dop = dopart(ws, pat); float* lse = (float*)(ws + WS_LSE) + (size_t)pat * S * 16;
#pragma unroll
    for (int i = 0; i < 8; ++i) { const int q = lane + 64 * i, row = q >> 4, ch = q & 15;
      *(u32x4*)(dop + (size_t)(c + d * (j0 + row)) * 2048 + h * 128 + ch * 8) = *(const FK_LAS u32x4*)(st + row * STG_ROW + ch * 16); }
    if (hi == 0) lse[(size_t)(c + d * (j0 + r32)) * 16 + h] = m_reg + __builtin_amdgcn_logf(l_reg);
  } else {
    if (hi == 0) al_l[32 + r32] = m_reg + __builtin_amdgcn_logf(l_reg); asm volatile("s_waitcnt lgkmcnt(0)" ::: "memory");
    const float* lse = (const float*)(ws + WS_LSE);
#pragma unroll
    for (int i = 0; i < 8; ++i) { const int q = lane + 64 * i, row = q >> 4, ch = q & 15; const int tok = c + d * (j0 + row);
      const u32x4 v2 = *(const FK_LAS u32x4*)(st + row * STG_ROW + ch * 16);
      const size_t off = (size_t)tok * 2048 + h * 128 + ch * 8;
      const u32x4 va = *(const u32x4*)(dopart(ws, 0) + off), vb = *(const u32x4*)(dopart(ws, 1) + off);
      const u32x4 gt = *(const u32x4*)(w.proj + (size_t)tok * PW + PC_GB + h * 128 + ch * 8);
      const float e0 = lse[(size_t)tok * 16 + h], e1 = lse[(size_t)(S + tok) * 16 + h], e2 = al_l[32 + row];
      const float mm = fmaxf(fmaxf(e0, e1), e2); float w0 = __builtin_amdgcn_exp2f(e0 - mm), w1 = __builtin_amdgcn_exp2f(e1 - mm), w2 = __builtin_amdgcn_exp2f(e2 - mm);
      const float inv = __builtin_amdgcn_rcpf(w0 + w1 + w2); w0 *= inv; w1 *= inv; w2 *= inv;
      u32x4 y; float ss = 0.f;
#pragma unroll
      for (int e = 0; e < 4; ++e) { const float x0 = w0 * bflo(va[e]) + w1 * bflo(vb[e]) + w2 * bflo(v2[e]), x1 = w0 * bfhi(va[e]) + w1 * bfhi(vb[e]) + w2 * bfhi(v2[e]);
        ss += x0 * x0 + x1 * x1; y[e] = cvt_pk_bf16(x0 * silu(bflo(gt[e])), x1 * silu(bfhi(gt[e]))); }
      *(u32x4*)(w.y + (size_t)tok * DM + 2048 + h * 128 + ch * 8) = y;
      ss += __shfl_xor(ss, 1); ss += __shfl_xor(ss, 2); ss += __shfl_xor(ss, 4); ss += __shfl_xor(ss, 8);
      if ((lane & 15) == 0) atomicAdd(w.ssq_b + tok, ss); }
  }
  asm volatile("s_waitcnt lgkmcnt(0)" ::: "memory");
}
}

#define XB_TMO      128
#define XB_XCNT(j)  (256  + 64 * (j))
#define XB_XSUB(j)  (1280 + 64 * (j))
#define XB_XGEN(j)  (2304 + 64 * (j))
#define XB_TOP      3328
#define XB_TOPGEN   3392
#define XCD_BAR_WORDS 3456
#define XB_SPIN_CAP (1u << 18)
constexpr size_t WS_BAR = 512 * 1024;
__device__ __forceinline__ unsigned xb_ld(unsigned* p)              { return __hip_atomic_load(p, __ATOMIC_RELAXED, __HIP_MEMORY_SCOPE_AGENT); }
__device__ __forceinline__ unsigned xb_add(unsigned* p, unsigned v) { return __hip_atomic_fetch_add(p, v, __ATOMIC_RELAXED, __HIP_MEMORY_SCOPE_AGENT); }
__device__ __forceinline__ unsigned xb_xcc_id() { return (unsigned)__builtin_amdgcn_s_getreg((3 << 11) | 20) & 0xFu; }
#define XB_SPIN(cond, bar) do { unsigned _sp = 0; while (cond) { __builtin_amdgcn_s_sleep(1); \
    if ((++_sp & 255u) == 0u) { if (xb_ld(&(bar)[XB_TMO])) break; if (_sp > XB_SPIN_CAP) { atomicAdd(&(bar)[XB_TMO], 1u); break; } } } } while (0)
struct XcdBarrier { unsigned* bar; unsigned x; volatile FK_LAS unsigned* st; };
__device__ __forceinline__ XcdBarrier xcd_barrier_post(unsigned* bar, volatile FK_LAS unsigned* st) {
  XcdBarrier b; b.bar = bar; b.x = xb_xcc_id(); b.st = st;
  if (threadIdx.x == 0) (void)xb_add(&bar[XB_XCNT(b.x)], 1u);
  return b;
}
__device__ __forceinline__ void xcd_barrier_complete(unsigned* bar, unsigned x, unsigned& nloc, unsigned& nx) {
  const unsigned G = gridDim.x * gridDim.y * gridDim.z;
  unsigned sum, cnt, mine, sp = 0u;
  for (;;) {
    sum = 0u; cnt = 0u; mine = 0u;
#pragma unroll
    for (unsigned j = 0; j < 16; ++j) { const unsigned c = xb_ld(&bar[XB_XCNT(j)]); sum += c; cnt += (c > 0u) ? 1u : 0u; mine = (j == x) ? c : mine; }
    if (sum == G) break;
    __builtin_amdgcn_s_sleep(1);
    if ((++sp & 255u) == 0u) { if (xb_ld(&bar[XB_TMO])) break; if (sp > XB_SPIN_CAP) { atomicAdd(&bar[XB_TMO], 1u); break; } }
  }
  nloc = mine > 0u ? mine : 1u; nx = cnt > 0u ? cnt : 1u;
}
__device__ __forceinline__ void xcd_barrier(const XcdBarrier& b) {
  asm volatile("s_waitcnt vmcnt(0)" ::: "memory");
  __syncthreads();
  if (threadIdx.x == 0) {
    unsigned* bar = b.bar;
    __builtin_amdgcn_s_waitcnt(0);
    unsigned nloc = b.st[0], nx = b.st[1];
    if (nloc == 0u) { xcd_barrier_complete(bar, b.x, nloc, nx); b.st[0] = nloc; b.st[1] = nx; }
    const unsigned old = xb_add(&bar[XB_XSUB(b.x)], 1u);
    const unsigned gen = old / nloc;
    if (old + 1u == (gen + 1u) * nloc) {
      __builtin_amdgcn_fence(__ATOMIC_RELEASE, "agent");
      asm volatile("s_waitcnt vmcnt(0)" ::: "memory");
      const unsigned og = xb_add(&bar[XB_TOP], 1u);
      const unsigned tg = og / nx;
      if (og + 1u == (tg + 1u) * nx) xb_add(&bar[XB_TOPGEN], 1u);
      else XB_SPIN(xb_ld(&bar[XB_TOPGEN]) == tg, bar);
      __builtin_amdgcn_fence(__ATOMIC_ACQUIRE, "agent");
      xb_add(&bar[XB_XGEN(b.x)], 1u);
      asm volatile("s_waitcnt vmcnt(0)" ::: "memory");
    } else {
      XB_SPIN(xb_ld(&bar[XB_XGEN(b.x)]) == gen, bar);
      __builtin_amdgcn_fence(__ATOMIC_ACQUIRE, "agent");
      asm volatile("s_waitcnt vmcnt(0)" ::: "memory");
    }
  }
  __syncthreads();
}

constexpr int LDS_BYTES = 151552;
struct Args { Ptrs P; int ph_lo, ph_hi; int dry, sub; };

__global__ void __launch_bounds__(512, 2) mega(Args a) {
  extern __shared__ __attribute__((aligned(16))) unsigned char lds_raw[];
  FK_LAS unsigned char* lds = (FK_LAS unsigned char*)lds_raw;
  const Ptrs& P = a.P;
  const int G = gridDim.x, bx = blockIdx.x; const int vcu = (G % 8 == 0) ? (bx % 8) * (G / 8) + bx / 8 : bx;
  const int tid = threadIdx.x, lane = tid & 63, wave = __builtin_amdgcn_readfirstlane(tid >> 6);
#ifndef FK_MLA_UNIT
#define FK_MLA_UNIT unit2
#endif
#ifndef FK_SUB_MASK
#define FK_SUB_MASK 15
#endif
#ifndef FK_PHASE_MASK
#define FK_PHASE_MASK 0x7f
#endif
#define IN(k) (((FK_PHASE_MASK >> (k)) & 1) && a.ph_lo <= (k) && (k) < a.ph_hi)
#ifndef FK_CG_SEAMS
#define FK_CG_SEAMS 0x01
#endif
#define SEAM(k) do { if (IN(k) && IN((k) + 1)) { if ((FK_CG_SEAMS >> (k)) & 1) cg::this_grid().sync(); else xcd_barrier(xbar); } } while (0)
  { volatile FK_LAS unsigned* st = (volatile FK_LAS unsigned*)(lds + LDS_BYTES - 64); if (tid < 2) st[tid] = 0u; __syncthreads(); }
  XcdBarrier xbar; xbar.bar = (unsigned*)(a.P.ws + WS_BAR); xbar.x = 0; xbar.st = nullptr;
  if (a.ph_lo == 0 && a.ph_hi > 1 && bx == 0) { unsigned* bw = (unsigned*)(a.P.ws + WS_BAR); for (int i = tid; i < XCD_BAR_WORDS; i += 512) bw[i] = 0u; }
#ifndef FK_DRY_PHASE
#define FK_DRY_PHASE (-1)
#endif
#ifndef FK_DRY_REPS
#define FK_DRY_REPS 1
#endif
#define RUN(k, ...) do { if (IN(k)) { const int dry = a.dry; __VA_ARGS__ } } while (0)
  RUN(0, { const W w = mkW(P.ws); prologue(P, w, lds, vcu, G); __syncthreads(); });
  SEAM(0);
  if (a.ph_lo == 0 && a.ph_hi > 1) xbar = xcd_barrier_post((unsigned*)(a.P.ws + WS_BAR), (volatile FK_LAS unsigned*)(lds + LDS_BYTES - 64));
  RUN(1, { W w = mkW(P.ws); if (dry) { w.ssq_q = w.dummy; w.ssq_kv = w.dummy; } pg8::Gemm g{w.xb, w.win, DM, DM, DM}; pg8::StaticOrder so; so.init(S, N1, G, bx);
    Epi1 E{w.proj, w.rs_x, w.ssq_q, w.ssq_kv, w.tab, w.kf}; pg8::gemm_phase<Epi1>(lds, g, so, E);
    constexpr int FULL = (S / 256) * (N1 / 256) % 256;
    if (G == 256 && bx >= FULL) { pg8::Gemm g2{w.pb, w.wple, 256, 256, 256}; pg8::StaticOrder so2; so2.init(S, DM, G - FULL, bx - FULL); EpiPle E2{w.ple, DM}; pg8::gemm_phase<EpiPle>(lds, g2, so2, E2); } });
  SEAM(1);
  RUN(2, { W w = mkW(P.ws);
    if (G == 256) {
      const bool lo = vcu < 128;
      if (FK_SUB_MASK & a.sub & 1) { pg8::Gemm g{w.proj + PC_CQ, w.wuq, PW, 1024, 1024}; pg8::ListOrder so{lo ? 2 * vcu : 128 + vcu, lo ? 2 : 1, 12}; Epi2a E{w.q, w.ssq_q, w.tab}; pg8::gemm_phase<Epi2a, pg8::ListOrder>(lds, g, so, E); }
      if (FK_SUB_MASK & a.sub & 2) { pg8::Gemm g{w.proj + PC_CKV, w.wukv, PW, 512, 512}; pg8::ListOrder so{lo ? vcu : 128 + 3 * (vcu - 128), lo ? 1 : 3, 16}; Epi2b E{w.kf, w.vf, w.ssq_kv}; pg8::gemm_phase<Epi2b, pg8::ListOrder>(lds, g, so, E); }
    } else {
      if (FK_SUB_MASK & a.sub & 1) { pg8::Gemm g{w.proj + PC_CQ, w.wuq, PW, 1024, 1024}; pg8::StaticOrder so; so.init(S, 3072, G, bx); Epi2a E{w.q, w.ssq_q, w.tab}; pg8::gemm_phase<Epi2a>(lds, g, so, E); }
      if (FK_SUB_MASK & a.sub & 2) { pg8::Gemm g{w.proj + PC_CKV, w.wukv, PW, 512, 512}; pg8::StaticOrder so; so.init(S, 4096, G, bx); Epi2b E{w.kf, w.vf, w.ssq_kv}; pg8::gemm_phase<Epi2b>(lds, g, so, E); }
    }
    if (G != 256) { pg8::Gemm g{w.pb, w.wple, 256, 256, 256}; pg8::StaticOrder so; so.init(S, DM, G, bx); EpiPle E{w.ple, DM}; pg8::gemm_phase<EpiPle>(lds, g, so, E); }
    if (FK_SUB_MASK & a.sub & 8) for (int it = vcu; it < 1024; it += G) { const int pat = it >> 9, idx = it & 511;
      const int dsh = pat * 2, ng = 32 >> dsh; const int qbg = idx & (ng - 1), cls = (idx >> (5 - dsh)) & ((1 << dsh) - 1), h = idx >> 5;
      dil::wg_item(lds, w, P.ws, pat, h, cls, qbg, wave, lane, dry ? (a.sub >> 8) : 0, false); }
    __syncthreads(); });
  SEAM(2);
  RUN(3, { W w = mkW(P.ws); if (dry) { w.ssq_a = w.dummy; w.ssq_b = w.dummy; }
    if (a.sub & 16) for (int it = vcu; it < 512; it += G) { const int qbg = it & 1, cls = (it >> 1) & 15, h = it >> 5;
      dil::wg_item(lds, w, P.ws, 2, h, cls, qbg, wave, lane, 0, true); }
    __syncthreads();
    if (a.sub & 32) for (int it = vcu; it < 512; it += G) mla::FK_MLA_UNIT(lds, w, it >> 5, (it & 31) * 256, 0); });
  SEAM(3);
  RUN(4, { W w = mkW(P.ws); if (dry) w.ssq_x1 = w.dummy; pg8::Gemm g{w.y, w.wout, DM, DM, DM}; pg8::StaticOrder so; so.init(S, DM, G, bx);
    Epi4 E{P.x, P.out, w.xb, w.ssq_a, w.ssq_b, w.ssq_x1}; pg8::gemm_phase<Epi4>(lds, g, so, E); });
  SEAM(4);
  RUN(5, { W w = mkW(P.ws); if (dry) w.ssq_x2 = w.dummy; pg8::Gemm g{w.xb, w.wpg, DM, DM, DM}; pg8::StaticOrder so; so.init(S, DM, G, bx);
    Epi5 E{w.xb, w.y, w.ple, w.ssq_x1, w.ssq_x2}; pg8::gemm_phase<Epi5>(lds, g, so, E); });
  SEAM(5);
  RUN(6, { const W w = mkW(P.ws); const int gt = vcu * 512 + tid, NGT = G * 512; f32x4* ow = dry ? (f32x4*)(P.ws + WS_Q) : (f32x4*)P.out;
    for (int i = gt; i < S * DM / 8; i += NGT) { const int row = i >> 9, c8 = i & 511; const float rs = rsqrtf(w.ssq_x2[row] * (1.f / 4096.f) + EPS);
      const f32x4 ga = ((const f32x4*)P.g_fin)[2 * c8], gb = ((const f32x4*)P.g_fin)[2 * c8 + 1]; const u32x4 xv = ((const u32x4*)w.y)[i];
      f32x4 a, b; a[0] = bflo(xv.x); a[1] = bfhi(xv.x); a[2] = bflo(xv.y); a[3] = bfhi(xv.y); b[0] = bflo(xv.z); b[1] = bfhi(xv.z); b[2] = bflo(xv.w); b[3] = bfhi(xv.w);
      ow[2 * i] = a * rs * ga; ow[2 * i + 1] = b * rs * gb; } });
#undef RUN
#undef IN
#undef SEAM
}

static inline Ptrs mkPtrs(void* const* d_in, void* d_out, void* d_ws) {
  Ptrs P{};
  P.x = (const float*)d_in[0]; P.p = (const float*)d_in[1]; P.pos = (const int*)d_in[2]; P.g_mix = (const float*)d_in[3]; P.w_in = (const float*)d_in[4];
  P.g_q = (const float*)d_in[5]; P.w_uq = (const float*)d_in[6]; P.g_kv = (const float*)d_in[7]; P.w_ukv = (const float*)d_in[8]; P.g_oa = (const float*)d_in[9];
  P.g_ob = (const float*)d_in[10]; P.w_out = (const float*)d_in[11]; P.w_ple = (const float*)d_in[12]; P.g_ple = (const float*)d_in[13]; P.w_pg = (const float*)d_in[14];
  P.g_fin = (const float*)d_in[15]; P.out = (float*)d_out; P.ws = (unsigned char*)d_ws;
  return P;
}
}


#ifndef FK_NLAUNCH
#define FK_NLAUNCH 1
#endif
extern "C" void kernel_launch(void* const* d_in, const int* in_sizes, int n_in, void* d_out, int out_size, void* d_ws, size_t ws_size, hipStream_t stream) {
  static int grid = 0;
  if (grid == 0) {
    if (n_in != 16 || out_size != fk::S * fk::DM || ws_size < fk::WS_END) { fprintf(stderr, "kernel_launch: unexpected shapes n_in %d out %d ws %zu\n", n_in, out_size, ws_size); grid = -1; return; }
    int dev = 0, cus = 0, per_cu = 0;
    (void)hipGetDevice(&dev); (void)hipDeviceGetAttribute(&cus, hipDeviceAttributeMultiprocessorCount, dev);
    if (hipFuncSetAttribute((const void*)fk::mega, hipFuncAttributeMaxDynamicSharedMemorySize, fk::LDS_BYTES) != hipSuccess) { fprintf(stderr, "kernel_launch: hipFuncSetAttribute failed\n"); grid = -1; return; }
    if (hipOccupancyMaxActiveBlocksPerMultiprocessor(&per_cu, (const void*)fk::mega, 512, fk::LDS_BYTES) != hipSuccess || per_cu < 1) { fprintf(stderr, "kernel_launch: occupancy query says %d workgroups per CU; nothing launched\n", per_cu); grid = -1; return; }
    grid = cus * 1;
  }
  if (grid < 0) return;
  fk::Args a{}; a.P = fk::mkPtrs(d_in, d_out, d_ws); a.sub = 63;
#if FK_NLAUNCH == 1
  a.ph_lo = 0; a.ph_hi = 7; a.dry = 0;
  void* args[] = {&a};
  hipError_t e = hipLaunchCooperativeKernel((const void*)fk::mega, dim3(grid), dim3(512), args, fk::LDS_BYTES, stream);
  if (e != hipSuccess) fprintf(stderr, "cooperative launch failed: %s (grid %d)\n", hipGetErrorString(e), grid);
#ifdef FK_PROBE_PHASE
  for (int r_ = 0; r_ < FK_PROBE_REPS; ++r_) { a.ph_lo = FK_PROBE_PHASE; a.ph_hi = FK_PROBE_PHASE + 1; a.dry = 1; a.sub = FK_PROBE_SUB; hipLaunchKernelGGL(fk::mega, dim3(grid), dim3(512), fk::LDS_BYTES, stream, a); }
#endif
#else
  for (int ph = 0; ph < 7; ++ph) { a.ph_lo = ph; a.ph_hi = ph + 1; a.dry = 0; hipLaunchKernelGGL(fk::mega, dim3(grid), dim3(512), fk::LDS_BYTES, stream, a); }
#endif
}
```
